# Optimizing an MI355X kernel written in HIP

```python
import math
import jax, jax.numpy as jnp
from jax import lax
import numpy as np

D_MODEL = 1024
BATCH = 32
SEQ = 256
DEPTH = 4
DEC_BATCH = 4
DEC_SEQ = 2048
PAST_LEN = 512

GRID_W = 64
N_S5_LAYERS = (DEPTH + 1) // 2
N_RET_LAYERS = DEPTH // 2
S5_WIDTH = D_MODEL // 2
CONV_WIDTH = D_MODEL - S5_WIDTH
S5_GROUP_CH = 16
S5_GROUPS = S5_WIDTH // S5_GROUP_CH
S5_STATE = 64
CONV_K = 3
HY_IN = S5_WIDTH + 3 * CONV_WIDTH
HY_MIX = S5_WIDTH + CONV_WIDTH
RET_HEADS = 8
RET_DK = D_MODEL // RET_HEADS
RET_DV = 2 * RET_DK
RET_QK = RET_HEADS * RET_DK
RET_V = RET_HEADS * RET_DV
RET_IN = 2 * RET_QK + 2 * RET_V
RET_CHUNK = 128
ROPE_BASE = 10000.0
MLP_HIDDEN = 4 * D_MODEL
N_MOD = 6
EPS = 1e-6

kernel_name = 'hybrid_s5_conv_retention_diffusion_step'

F32 = jnp.float32


def rms_norm(x, w):
    xf = x.astype(F32)
    y = xf * lax.rsqrt(jnp.mean(xf * xf, axis=-1, keepdims=True) + EPS)
    return (y * w.astype(F32)).astype(x.dtype)


def _cmul(ar, ai, br, bi):
    return ar * br - ai * bi, ar * bi + ai * br


def s5_direction(ug, lam_re, lam_im, log_step, b_re, b_im, c_re, c_im, h0, reverse):
    dt = jnp.exp(log_step.astype(F32))[:, None]
    lam_re = lam_re.astype(F32)
    lam_im = lam_im.astype(F32)
    mag = jnp.exp(lam_re * dt)
    ab_re, ab_im = mag * jnp.cos(lam_im * dt), mag * jnp.sin(lam_im * dt)
    den = lam_re * lam_re + lam_im * lam_im
    f_re = ((ab_re - 1.0) * lam_re + ab_im * lam_im) / den
    f_im = (ab_im * lam_re - (ab_re - 1.0) * lam_im) / den
    bb_re, bb_im = _cmul(f_re[..., None], f_im[..., None], b_re.astype(F32), b_im.astype(F32))
    bu_re = jnp.einsum('blgc,gpc->blgp', ug, bb_re)
    bu_im = jnp.einsum('blgc,gpc->blgp', ug, bb_im)
    if h0 is not None:
        h_re, h_im = _cmul(ab_re, ab_im, h0[0], h0[1])
        first = -1 if reverse else 0
        bu_re = bu_re.at[:, first].add(h_re)
        bu_im = bu_im.at[:, first].add(h_im)
    a_re = jnp.broadcast_to(ab_re, bu_re.shape)
    a_im = jnp.broadcast_to(ab_im, bu_im.shape)

    def combine(e1, e2):
        a1r, a1i, b1r, b1i = e1
        a2r, a2i, b2r, b2i = e2
        ar, ai = _cmul(a2r, a2i, a1r, a1i)
        br, bi = _cmul(a2r, a2i, b1r, b1i)
        return ar, ai, br + b2r, bi + b2i

    _, _, x_re, x_im = lax.associative_scan(combine, (a_re, a_im, bu_re, bu_im), axis=1, reverse=reverse)
    y = (jnp.einsum('blgp,gcp->blgc', x_re, c_re.astype(F32))
         - jnp.einsum('blgp,gcp->blgc', x_im, c_im.astype(F32)))
    last = 0 if reverse else -1
    return y, x_re[:, last], x_im[:, last]


def s5_mixer(u, lam_re, lam_im, log_step, b_re, b_im, c_re, c_im, d, h0_re, h0_im):
    bsz, length, _ = u.shape
    uf = u.astype(F32)
    ug = uf.reshape(bsz, length, S5_GROUPS, S5_GROUP_CH)
    y = d.astype(F32) * uf
    fin_re, fin_im = [], []
    for direction in range(2):
        h0 = None if h0_re is None else (h0_re[:, direction].astype(F32), h0_im[:, direction].astype(F32))
        yd, fr, fi = s5_direction(ug, lam_re[direction], lam_im[direction], log_step[direction],
                                  b_re[direction], b_im[direction], c_re[direction], c_im[direction],
                                  h0, reverse=(direction == 1))
        y = y + yd.reshape(bsz, length, S5_WIDTH)
        fin_re.append(fr)
        fin_im.append(fi)
    return y, jnp.stack(fin_re, 1), jnp.stack(fin_im, 1)


def short_conv(h, w, b):
    out = lax.conv_general_dilated(h, w[:, None, :].astype(h.dtype), window_strides=(1,),
                                   padding=((CONV_K // 2, CONV_K // 2),),
                                   dimension_numbers=('NWC', 'WIO', 'NWC'),
                                   feature_group_count=h.shape[-1])
    return out + b.astype(h.dtype)


def hybrid_mixer(h, in_w, out_w, lam_re, lam_im, log_step, b_re, b_im, c_re, c_im, d,
                 glu_w, glu_b, conv_w, conv_b, h0_re, h0_im):
    proj = h @ in_w
    u, bg, cg, v = jnp.split(proj, [S5_WIDTH, S5_WIDTH + CONV_WIDTH, S5_WIDTH + 2 * CONV_WIDTH], axis=-1)
    y, s_re, s_im = s5_mixer(u, lam_re, lam_im, log_step, b_re, b_im, c_re, c_im, d, h0_re, h0_im)
    z = jax.nn.gelu(y)
    a_out = z * jax.nn.sigmoid(z @ glu_w.astype(F32) + glu_b.astype(F32))
    b_out = bg * short_conv(cg * v, conv_w, conv_b)
    mixed = jnp.concatenate([a_out.astype(b_out.dtype), b_out], axis=-1)
    return mixed @ out_w, s_re, s_im


def axial_rotary(t):
    length = t.shape[1]
    rows = length // GRID_W
    row = jnp.repeat(jnp.arange(rows, dtype=F32), GRID_W)
    col = jnp.tile(jnp.arange(GRID_W, dtype=F32), rows)
    n_freq = RET_DK // 4
    inv_freq = jnp.power(ROPE_BASE, -jnp.arange(n_freq, dtype=F32) / n_freq)

    def rot(x, pos):
        ang = pos[:, None] * inv_freq
        cos = jnp.cos(ang)[:, None, :]
        sin = jnp.sin(ang)[:, None, :]
        x1, x2 = x[..., :n_freq], x[..., n_freq:]
        return jnp.concatenate([x1 * cos - x2 * sin, x1 * sin + x2 * cos], axis=-1)

    half = RET_DK // 2
    return jnp.concatenate([rot(t[..., :half], row), rot(t[..., half:], col)], axis=-1)


def retention_chunked(q, k, v, log_g, s0):
    bsz, length, _, _ = q.shape
    n_chunks = length // RET_CHUNK
    idx = jnp.arange(RET_CHUNK, dtype=F32)
    diff = idx[:, None] - idx[None, :]
    intra = jnp.where(diff >= 0, jnp.exp(log_g[:, None, None] * jnp.maximum(diff, 0.0)), 0.0)
    q_decay = jnp.exp(log_g[None, :] * (idx[:, None] + 1.0))[None, :, :, None]
    k_decay = jnp.exp(log_g[None, :] * (RET_CHUNK - 1.0 - idx[:, None]))[None, :, :, None]
    chunk_decay = jnp.exp(log_g * RET_CHUNK)[None, :, None, None]
    if s0 is None:
        s0 = jnp.zeros((bsz, RET_HEADS, RET_DK, RET_DV), F32)

    def to_chunks(t):
        return jnp.moveaxis(t.reshape(bsz, n_chunks, RET_CHUNK, t.shape[2], t.shape[3]), 1, 0)

    def step(s, qkv):
        qc, kc, vc = qkv
        scores = jnp.einsum('bihd,bjhd->bhij', qc, kc) * intra
        o = (jnp.einsum('bhij,bjhe->bihe', scores, vc)
             + jnp.einsum('bihd,bhde->bihe', qc, s) * q_decay)
        s = s * chunk_decay + jnp.einsum('bjhd,bjhe->bhde', kc * k_decay, vc)
        return s, o

    s_fin, o = lax.scan(step, s0, (to_chunks(q), to_chunks(k), to_chunks(v)))
    o = jnp.moveaxis(o, 0, 1).reshape(bsz, length, RET_HEADS, RET_DV)
    return o, s_fin


def retention_mixer(h, in_w, out_w, gamma_logit, gn_w, s0):
    latent = s0 is not None
    bsz, length, _ = h.shape
    proj = h @ in_w
    q, k, v, g = jnp.split(proj, [RET_QK, 2 * RET_QK, 2 * RET_QK + RET_V], axis=-1)
    q = q.astype(F32).reshape(bsz, length, RET_HEADS, RET_DK)
    k = k.astype(F32).reshape(bsz, length, RET_HEADS, RET_DK)
    v = v.astype(F32).reshape(bsz, length, RET_HEADS, RET_DV)
    if latent:
        q = axial_rotary(q)
        k = axial_rotary(k)
    q = q * (RET_DK ** -0.5)
    log_g = jax.nn.log_sigmoid(gamma_logit.astype(F32))
    s0_f = s0[:, 0].astype(F32) if latent else None
    s0_b = s0[:, 1].astype(F32) if latent else None
    o_f, s_f = retention_chunked(q, k, v, log_g[0], s0_f)
    o_b, s_b = retention_chunked(jnp.flip(q, 1), jnp.flip(k, 1), jnp.flip(v, 1), log_g[1], s0_b)
    o = o_f + jnp.flip(o_b, 1)
    o = o * lax.rsqrt(jnp.mean(o * o, axis=-1, keepdims=True) + EPS) * gn_w.astype(F32).reshape(RET_HEADS, RET_DV)
    o = jax.nn.silu(g.astype(F32)) * o.reshape(bsz, length, RET_V)
    return o.astype(h.dtype) @ out_w, jnp.stack([s_f, s_b], axis=1)


def squared_relu_mlp(h, w1, w2):
    a = jax.nn.relu(h @ w1)
    return (a * a) @ w2


def run_trunk(x, cond, prm, s5_re0, s5_im0, ret0):
    latent = ret0 is not None
    sc = jax.nn.silu(cond)
    new_re, new_im, new_ret = [], [], []
    for i in range(DEPTH):
        j = i // 2
        mod = sc @ prm['ada_w'][i] + prm['ada_b'][i]
        sh1, sc1, g1, sh2, sc2, g2 = jnp.split(mod[:, None, :], N_MOD, axis=-1)
        h = rms_norm(x, prm['norm1_w'][i]) * (1.0 + sc1) + sh1
        if i % 2 == 0:
            out, s_re, s_im = hybrid_mixer(
                h, prm['hy_in_w'][j], prm['hy_out_w'][j],
                prm['s5_lam_re'][j], prm['s5_lam_im'][j], prm['s5_log_step'][j],
                prm['s5_b_re'][j], prm['s5_b_im'][j], prm['s5_c_re'][j], prm['s5_c_im'][j],
                prm['s5_d'][j], prm['s5_glu_w'][j], prm['s5_glu_b'][j],
                prm['conv_w'][j], prm['conv_b'][j],
                s5_re0[:, j] if latent else None, s5_im0[:, j] if latent else None)
            new_re.append(s_re)
            new_im.append(s_im)
        else:
            out, s_ret = retention_mixer(h, prm['ret_in_w'][j], prm['ret_out_w'][j],
                                         prm['ret_gamma_logit'][j], prm['ret_gn_w'][j],
                                         ret0[:, j] if latent else None)
            new_ret.append(s_ret)
        x = x + g1 * out
        h = rms_norm(x, prm['norm2_w'][i]) * (1.0 + sc2) + sh2
        x = x + g2 * squared_relu_mlp(h, prm['mlp_w1'][i], prm['mlp_w2'][i])
    y = rms_norm(x, prm['final_norm_w'])
    if latent:
        return y
    return y, jnp.stack(new_re, 1), jnp.stack(new_im, 1), jnp.stack(new_ret, 1)


def setup_inputs(seed: int = 0) -> dict:
    key = jax.random.key(seed)
    ks = jax.random.split(key, 32)
    D = D_MODEL

    def nrm(k, shape, s):
        return jax.random.normal(k, shape, F32) * s

    gam = 1.0 - jnp.power(2.0, -5.0 - jnp.arange(RET_HEADS, dtype=F32))
    ret_scale = jnp.sqrt((1.0 - gam ** (2 * PAST_LEN)) / (1.0 - gam * gam))
    s5_shape = (N_S5_LAYERS, 2, S5_GROUPS, S5_STATE)
    return {
        'x_prompt': nrm(ks[0], (BATCH, SEQ, D), 1.0),
        'x_sample': nrm(ks[1], (DEC_BATCH, DEC_SEQ, D), 1.0),
        'state_s5_re': nrm(ks[2], (DEC_BATCH,) + s5_shape, 1.0),
        'state_s5_im': nrm(ks[3], (DEC_BATCH,) + s5_shape, 1.0),
        'state_ret': nrm(ks[4], (DEC_BATCH, N_RET_LAYERS, 2, RET_HEADS, RET_DK, RET_DV), 1.0) * ret_scale[:, None, None],
        'c': nrm(ks[5], (DEC_BATCH, D), 1.0),
        'c_ctx': nrm(ks[6], (D,), 1.0),
        'norm1_w': 1.0 + nrm(ks[7], (DEPTH, D), 0.02),
        'norm2_w': 1.0 + nrm(ks[8], (DEPTH, D), 0.02),
        'ada_w': nrm(ks[9], (DEPTH, D, N_MOD * D), 0.5 * D ** -0.5),
        'ada_b': nrm(ks[10], (DEPTH, N_MOD * D), 0.02),
        'hy_in_w': nrm(ks[11], (N_S5_LAYERS, D, HY_IN), D ** -0.5),
        'hy_out_w': nrm(ks[12], (N_S5_LAYERS, HY_MIX, D), HY_MIX ** -0.5),
        's5_lam_re': -0.5 + nrm(ks[13], s5_shape, 0.01),
        's5_lam_im': math.pi * jnp.arange(S5_STATE, dtype=F32) + nrm(ks[14], s5_shape, 0.01),
        's5_log_step': jax.random.uniform(ks[15], (N_S5_LAYERS, 2, S5_GROUPS), F32, math.log(1e-3), math.log(1e-1)),
        's5_b_re': nrm(ks[16], s5_shape + (S5_GROUP_CH,), (2 * S5_GROUP_CH) ** -0.5),
        's5_b_im': nrm(ks[17], s5_shape + (S5_GROUP_CH,), (2 * S5_GROUP_CH) ** -0.5),
        's5_c_re': nrm(ks[18], (N_S5_LAYERS, 2, S5_GROUPS, S5_GROUP_CH, S5_STATE), (2 * S5_STATE) ** -0.5),
        's5_c_im': nrm(ks[19], (N_S5_LAYERS, 2, S5_GROUPS, S5_GROUP_CH, S5_STATE), (2 * S5_STATE) ** -0.5),
        's5_d': nrm(ks[20], (N_S5_LAYERS, S5_WIDTH), 1.0),
        's5_glu_w': nrm(ks[21], (N_S5_LAYERS, S5_WIDTH, S5_WIDTH), S5_WIDTH ** -0.5),
        's5_glu_b': nrm(ks[22], (N_S5_LAYERS, S5_WIDTH), 0.02),
        'conv_w': nrm(ks[23], (N_S5_LAYERS, CONV_K, CONV_WIDTH), CONV_K ** -0.5),
        'conv_b': nrm(ks[24], (N_S5_LAYERS, CONV_WIDTH), 0.02),
        'ret_in_w': nrm(ks[25], (N_RET_LAYERS, D, RET_IN), D ** -0.5),
        'ret_out_w': nrm(ks[26], (N_RET_LAYERS, RET_V, D), RET_V ** -0.5),
        'ret_gamma_logit': jnp.log(gam / (1.0 - gam)) + nrm(ks[27], (N_RET_LAYERS, 2, RET_HEADS), 0.05),
        'ret_gn_w': 1.0 + nrm(ks[28], (N_RET_LAYERS, RET_V), 0.02),
        'mlp_w1': nrm(ks[29], (DEPTH, D, MLP_HIDDEN), D ** -0.5),
        'mlp_w2': nrm(ks[30], (DEPTH, MLP_HIDDEN, D), MLP_HIDDEN ** -0.5),
        'final_norm_w': 1.0 + nrm(ks[31], (D,), 0.02),
    }


def reference(x_prompt, x_sample, state_s5_re, state_s5_im, state_ret, c, c_ctx,
              norm1_w, norm2_w, ada_w, ada_b, hy_in_w, hy_out_w,
              s5_lam_re, s5_lam_im, s5_log_step, s5_b_re, s5_b_im, s5_c_re, s5_c_im,
              s5_d, s5_glu_w, s5_glu_b, conv_w, conv_b,
              ret_in_w, ret_out_w, ret_gamma_logit, ret_gn_w,
              mlp_w1, mlp_w2, final_norm_w):
    prm = dict(norm1_w=norm1_w, norm2_w=norm2_w, ada_w=ada_w, ada_b=ada_b,
               hy_in_w=hy_in_w, hy_out_w=hy_out_w,
               s5_lam_re=s5_lam_re, s5_lam_im=s5_lam_im, s5_log_step=s5_log_step,
               s5_b_re=s5_b_re, s5_b_im=s5_b_im, s5_c_re=s5_c_re, s5_c_im=s5_c_im,
               s5_d=s5_d, s5_glu_w=s5_glu_w, s5_glu_b=s5_glu_b,
               conv_w=conv_w, conv_b=conv_b,
               ret_in_w=ret_in_w, ret_out_w=ret_out_w, ret_gamma_logit=ret_gamma_logit, ret_gn_w=ret_gn_w,
               mlp_w1=mlp_w1, mlp_w2=mlp_w2, final_norm_w=final_norm_w)
    y_prompt, new_s5_re, new_s5_im, new_ret = run_trunk(x_prompt, c_ctx[None, :], prm, None, None, None)
    y_sample = run_trunk(x_sample, c, prm, state_s5_re, state_s5_im, state_ret)
    return (y_prompt, y_sample, new_s5_re, new_s5_im, new_ret)
```

```cpp
#include <hip/hip_runtime.h>
#include <hip/hip_cooperative_groups.h>
#include <cstdio>
#include <cstdint>
namespace cg = cooperative_groups;

#ifndef MK_MULTI
#define MK_MULTI 0
#endif

#define DI __device__ __forceinline__
#define LAS __attribute__((address_space(3)))
typedef unsigned short bf16_t;
typedef short bf16x8 __attribute__((ext_vector_type(8)));
typedef short s16x4 __attribute__((ext_vector_type(4)));
typedef float f32x4 __attribute__((ext_vector_type(4)));
typedef float f32x16 __attribute__((ext_vector_type(16)));
typedef unsigned u32x4 __attribute__((ext_vector_type(4)));
typedef unsigned u32x2 __attribute__((ext_vector_type(2)));

constexpr int D = 1024, NTOK = 16384, NCTX = 8192, DEPTH = 4;
constexpr int HY_IN = 2048, RET_IN = 6144, FF = 4096;
constexpr float EPS = 1e-6f;
constexpr int NWAVES = 8;
constexpr int LDS_BYTES = 147456;
enum { I_XP = 0, I_XS, I_S5RE, I_S5IM, I_SRET, I_C, I_CCTX, I_N1W, I_N2W, I_ADAW, I_ADAB, I_HYIN, I_HYOUT, I_LAMRE, I_LAMIM, I_LOGSTEP,
       I_BRE, I_BIM, I_CRE, I_CIM, I_S5D, I_GLUW, I_GLUB, I_CONVW, I_CONVB, I_RETIN, I_RETOUT, I_GAMMA, I_GNW, I_W1, I_W2, I_FNW };
constexpr size_t O_S5RE = 16777216, O_S5IM = 16777216 + 262144, O_RET = 16777216 + 2 * 262144;
constexpr size_t MiB = 1u << 20;
constexpr size_t WS_MODP = 1 * MiB, WS_MOD = 9 * MiB, WS_LOC = 10 * MiB;
constexpr size_t WS_ROWSS = 377 * MiB, WS_GAIN = 378 * MiB, WS_SHW = 379 * MiB;

constexpr size_t WS_HYIN = 12 * MiB, WS_HYOUT = 20 * MiB, WS_GLU = 24 * MiB, WS_RETIN = 25 * MiB, WS_RETOUT = 49 * MiB, WS_W1 = 57 * MiB, WS_W2 = 89 * MiB;
constexpr size_t WS_XN = 121 * MiB, WS_A = 153 * MiB, WS_LOCAL = 345 * MiB, WS_END = 380 * MiB;
constexpr size_t A_YF = 64 * MiB, A_Z = 96 * MiB, A_MIX = 112 * MiB, A_YB = 144 * MiB, A_UB = 176 * MiB;
constexpr size_t A_OG = 128 * MiB;
constexpr int QKV_LD = 512;

struct Args { const float* in[32]; float* out; unsigned char* ws; int lo, hi; };
struct Ctx { const Args* t;
    __device__ __forceinline__ const float* in(int k) const { unsigned long long r; asm volatile("s_load_dwordx2 %0, %1, %2\n\ts_waitcnt lgkmcnt(0)" : "=s"(r) : "s"(t), "s"(k * 8) : "memory"); return (const float*)(const __attribute__((address_space(1))) float*)r; }
    __device__ __forceinline__ float* out() const { unsigned long long r; asm volatile("s_load_dwordx2 %0, %1, 0x100\n\ts_waitcnt lgkmcnt(0)" : "=s"(r) : "s"(t) : "memory"); return (float*)(__attribute__((address_space(1))) float*)r; }
    __device__ __forceinline__ unsigned char* ws() const { return (unsigned char*)(__attribute__((address_space(1))) unsigned char*)(unsigned long long)t; } };

typedef float f32x2_ __attribute__((ext_vector_type(2)));
typedef __bf16 bf16x2_ __attribute__((ext_vector_type(2)));
DI unsigned pk2(float lo, float hi) { const f32x2_ v = {lo, hi}; return __builtin_bit_cast(unsigned, __builtin_convertvector(v, bf16x2_)); }
DI unsigned f2bf(float f) { return pk2(f, 0.f) & 0xffffu; }
DI unsigned cvt_pk_bf16(float lo, float hi) { unsigned r; asm volatile("v_cvt_pk_bf16_f32 %0, %1, %2" : "=v"(r) : "v"(lo), "v"(hi)); return r; }
DI float bf2f(unsigned b) { return __builtin_bit_cast(float, b << 16); }
DI float bflo(unsigned w) { return __builtin_bit_cast(float, w << 16); }
DI float bfhi(unsigned w) { return __builtin_bit_cast(float, w & 0xffff0000u); }
DI float shfl_xor_l(float v, int o, int lane) { return __builtin_bit_cast(float, __builtin_amdgcn_ds_bpermute((lane ^ o) << 2, __builtin_bit_cast(int, v))); }
DI float wave_sum(float v, int lane) {
#pragma unroll
    for (int o = 1; o < 64; o <<= 1) v += shfl_xor_l(v, o, lane);
    return v;
}
DI int crow(int reg, int h) { return (reg & 3) + 8 * (reg >> 2) + 4 * h; }
DI float sigmoidf_(float x) { return __builtin_amdgcn_rcpf(1.f + __expf(-x)); }
DI float siluf_(float x) { return x * sigmoidf_(x); }
DI float gelu_tanh(float x) { const float u = 0.7978845608028654f * (x + 0.044715f * x * x * x); const float e = __expf(2.f * u); return x * (1.f - __builtin_amdgcn_rcpf(e + 1.f)); }
DI int cond_of_row(int r) { return r < NCTX ? 0 : 1 + ((r - NCTX) >> 11); }
#define MFMA32(a, b, c) __builtin_amdgcn_mfma_f32_32x32x16_bf16((a), (b), (c), 0, 0, 0)
#define MFMA16(a, b, c) __builtin_amdgcn_mfma_f32_16x16x32_bf16((a), (b), (c), 0, 0, 0)
#define LDS_WAIT() asm volatile("s_waitcnt lgkmcnt(0)" ::: "memory")
#define CFENCE() do { asm volatile("" ::: "memory"); __builtin_amdgcn_sched_barrier(0); } while (0)
#define WAVE_SYNC() do { asm volatile("s_waitcnt lgkmcnt(0)" ::: "memory"); __builtin_amdgcn_wave_barrier(); } while (0)

namespace pg8 {
constexpr int BM = 256, BK = 64, HALF = 128, HTB = HALF * BK * 2, STAGE_BYTES = 8 * HTB, NXCD = 8, WGM = 8;
DI int lds_byte(int r, int c) { const int st = (r >> 4) * 2 + (c >> 5), rr = r & 15, cc = c & 31, ob = rr * 64 + cc * 2; return st * 1024 + (ob ^ (((ob >> 9) & 1) << 5)); }
DI void stage_rc(int b, int& R, int& C) { const int st = b / 1024, sb = b % 1024, swz = sb ^ (((sb >> 9) & 1) << 5); R = (st >> 1) * 16 + swz / 64; C = (st & 1) * 32 + (swz % 64) / 2; }
DI int perm32(int rho) { const int n = rho >> 4, i = rho & 15; return 8 * (i >> 2) + 4 * n + (i & 3); }
struct Unit { int pm, pn; };
struct Gemm { const bf16_t* A; const bf16_t* Bt; int M, N, K, lda; };
struct StaticOrder {
    int nM, nN, nwg, G, c;
    DI void init(int M, int N, int G_, int c_) { nM = M / BM; nN = N / BM; nwg = nM * nN; G = G_; c = c_; }
    DI bool next(int i, Unit& u) const {
        const long L = (long)i * G + c; if (L >= nwg) return false;
        int wgid = (int)L; { const int q = nwg / NXCD, r = nwg % NXCD, xcd = wgid % NXCD, off = wgid / NXCD; wgid = (xcd < r ? xcd * (q + 1) : r * (q + 1) + (xcd - r) * q) + off; }
        const int nig = WGM * nN, gid = wgid / nig, fm = gid * WGM, gsz = (nM - fm) < WGM ? (nM - fm) : WGM;
        u.pm = fm + ((wgid % nig) % gsz); u.pn = (wgid % nig) / gsz; return true;
    }
};
template <class Epi>
DI void gemm_phase(LAS unsigned char* lds, const Gemm g, const StaticOrder& S, const Epi& E, const int tid) {
    const int wid = __builtin_amdgcn_readfirstlane(tid >> 6), lane = tid & 63, wr = wid >> 2, wc = wid & 3, fr = lane & 15, fq = lane >> 4;
    const int K = g.K, nt = K / BK, lda = g.lda;
    unsigned voffA[2], voffB[2];
#pragma unroll
    for (int i = 0; i < 2; ++i) { int R, C; stage_rc(tid * 16 + i * 8192, R, C); const int Rb = (R & ~31) + perm32(R & 31);
        voffA[i] = (unsigned)(R * lda + C) * 2u; voffB[i] = (unsigned)(Rb * K + C) * 2u; }
    const size_t kstep = (size_t)(BK * 2);
    const size_t hstepA = (size_t)HALF * lda * 2, hstepB = (size_t)HALF * K * 2;
    const size_t tstepA = 2 * hstepA, tstepB = 2 * hstepB;
    const unsigned ldsw = (unsigned)wid * 1024u;
    const int aoff = lds_byte(wr * 64 + fr, fq * 8), boff = lds_byte(wc * 32 + fr, fq * 8);
#define PG8_SA(b, h) (((b) * 2 + (h)) * HTB)
#define PG8_SB(b, h) ((4 + (b) * 2 + (h)) * HTB)
#define PG8_STAGE(bufoff, gbase, voff) do { _Pragma("unroll") for (int _i = 0; _i < 2; ++_i) \
        __builtin_amdgcn_global_load_lds((const unsigned*)((const char*)(gbase) + (voff)[_i]), (LAS unsigned*)(lds + (bufoff) + ldsw + _i * 8192), 16, 0, 0); } while (0)
#define PG8_LDA(dst, b, h) do { _Pragma("unroll") for (int m = 0; m < 4; ++m) _Pragma("unroll") for (int k = 0; k < 2; ++k) dst[m][k] = *(const LAS bf16x8*)(lds + PG8_SA(b, h) + aoff + m * 2048 + k * 1024); } while (0)
#define PG8_LDB(dst, b, h) do { _Pragma("unroll") for (int n = 0; n < 2; ++n) _Pragma("unroll") for (int k = 0; k < 2; ++k) dst[n][k] = *(const LAS bf16x8*)(lds + PG8_SB(b, h) + boff + n * 2048 + k * 1024); } while (0)
#define PG8_MMA(ai, bj, At, Bt) do { __builtin_amdgcn_s_setprio(1); _Pragma("unroll") for (int m = 0; m < 4; ++m) _Pragma("unroll") for (int n = 0; n < 2; ++n) _Pragma("unroll") for (int k = 0; k < 2; ++k) \
        acc[ai][bj][m][n] = __builtin_amdgcn_mfma_f32_16x16x32_bf16(Bt[n][k], At[m][k], acc[ai][bj][m][n], 0, 0, 0); __builtin_amdgcn_s_setprio(0); } while (0)
#define PG8_WAIT_V(n) asm volatile("s_waitcnt vmcnt(" #n ")" ::: "memory")
#define PG8_WAIT_L(n) asm volatile("s_waitcnt lgkmcnt(" #n ")" ::: "memory")
#define PG8_BAR __builtin_amdgcn_s_barrier()
#define PG8_SCHED __builtin_amdgcn_sched_barrier(0)
    Unit cur, nxt; int ui = 0;
    if (!S.next(0, cur)) return;
    f32x4 acc[2][2][4][2];
#pragma unroll
    for (int a = 0; a < 2; ++a)
#pragma unroll
        for (int b = 0; b < 2; ++b)
#pragma unroll
            for (int m = 0; m < 4; ++m)
#pragma unroll
                for (int n = 0; n < 2; ++n) acc[a][b][m][n] = (f32x4){0.f, 0.f, 0.f, 0.f};
    bf16x8 At[4][2], B0[2][2], B1[2][2];
    const char* cA = (const char*)g.A + (size_t)cur.pm * tstepA; const char* cB = (const char*)g.Bt + (size_t)cur.pn * tstepB;
    PG8_STAGE(PG8_SB(0, 0), cB, voffB); PG8_STAGE(PG8_SB(0, 1), cB + hstepB, voffB); PG8_STAGE(PG8_SA(0, 0), cA, voffA); PG8_STAGE(PG8_SA(0, 1), cA + hstepA, voffA);
    if (wr == 1) PG8_BAR;
    PG8_WAIT_V(2); PG8_BAR;
    PG8_STAGE(PG8_SB(1, 0), cB + kstep, voffB); PG8_STAGE(PG8_SA(1, 0), cA + kstep, voffA); PG8_STAGE(PG8_SB(1, 1), cB + hstepB + kstep, voffB);
    PG8_WAIT_V(6); PG8_BAR;
    for (;;) {
        const bool has_next = S.next(ui + 1, nxt);
        const char* nA = has_next ? (const char*)g.A + (size_t)nxt.pm * tstepA : cA; const char* nB = has_next ? (const char*)g.Bt + (size_t)nxt.pn * tstepB : cB;
        for (int t = 0; t < nt; t += 2) {
            const bool last = (t == nt - 2);
            const char* a1 = cA + (size_t)(t + 1) * kstep;
            const char* a2 = last ? nA : cA + (size_t)(t + 2) * kstep; const char* b2 = last ? nB : cB + (size_t)(t + 2) * kstep;
            const char* a3 = a2 + kstep; const char* b3 = b2 + kstep;
            PG8_LDB(B0, 0, 0); PG8_LDB(B1, 0, 1); PG8_SCHED; PG8_LDA(At, 0, 0); PG8_STAGE(PG8_SA(1, 1), a1 + hstepA, voffA);
            PG8_WAIT_V(8); PG8_WAIT_L(0); PG8_BAR; PG8_MMA(0, 0, At, B0); PG8_MMA(0, 1, At, B1); PG8_BAR; PG8_SCHED;
            PG8_LDA(At, 0, 1); PG8_STAGE(PG8_SB(0, 0), b2, voffB); PG8_STAGE(PG8_SB(0, 1), b2 + hstepB, voffB); PG8_STAGE(PG8_SA(0, 0), a2, voffA);
            PG8_WAIT_V(8); PG8_WAIT_L(0); PG8_BAR; PG8_MMA(1, 0, At, B0); PG8_MMA(1, 1, At, B1); PG8_BAR; PG8_SCHED;
            PG8_LDB(B0, 1, 0); PG8_LDB(B1, 1, 1); PG8_SCHED; PG8_LDA(At, 1, 0); PG8_STAGE(PG8_SA(0, 1), a2 + hstepA, voffA);
            PG8_WAIT_V(8); PG8_WAIT_L(0); PG8_BAR; PG8_MMA(0, 0, At, B0); PG8_MMA(0, 1, At, B1); PG8_BAR; PG8_SCHED;
            PG8_LDA(At, 1, 1); PG8_STAGE(PG8_SB(1, 0), b3, voffB); PG8_STAGE(PG8_SB(1, 1), b3 + hstepB, voffB); PG8_STAGE(PG8_SA(1, 0), a3, voffA);
            PG8_WAIT_V(8); PG8_WAIT_L(0); PG8_BAR; PG8_MMA(1, 0, At, B0); PG8_MMA(1, 1, At, B1); PG8_BAR; PG8_SCHED;
        }
        if (wr == 0) PG8_BAR;
        E(acc, cur, wr, wc, fr, fq);
        if (!has_next) break;
#pragma unroll
        for (int a = 0; a < 2; ++a)
#pragma unroll
            for (int b = 0; b < 2; ++b)
#pragma unroll
                for (int m = 0; m < 4; ++m)
#pragma unroll
                    for (int n = 0; n < 2; ++n) acc[a][b][m][n] = (f32x4){0.f, 0.f, 0.f, 0.f};
        cur = nxt; cA = nA; cB = nB; ++ui;
        if (wr == 1) PG8_BAR;
    }
    PG8_WAIT_V(0);
    PG8_BAR;
#undef PG8_SA
#undef PG8_SB
#undef PG8_STAGE
#undef PG8_LDA
#undef PG8_LDB
#undef PG8_MMA
#undef PG8_WAIT_V
#undef PG8_WAIT_L
#undef PG8_BAR
#undef PG8_SCHED
}
}

template <int MODE> struct Epi {
    bf16_t* O; int ldc;
    const float* rowss; const float* shw;
    bf16_t* xn; const float* gain; float* rowss_out;
    const float* bias; const bf16_t* Zp; int ldz;
    const float* base0; const float* base1; float* out; const float* gate;
    DI void operator()(const f32x4 (&acc)[2][2][4][2], const pg8::Unit& u, int wr, int wc, int fr, int fq) const {
        using namespace pg8;
        const int row0 = u.pm * BM + wr * 64 + fr, col0 = u.pn * BM + wc * 32 + 8 * fq;
        const float* shp = shw + (size_t)cond_of_row(u.pm * BM) * 6144 + col0;
        if constexpr (MODE == 0 || MODE == 1) {
            f32x4 sw[2][2];
#pragma unroll
            for (int bj = 0; bj < 2; ++bj) { sw[bj][0] = *(const f32x4*)(shp + bj * HALF); sw[bj][1] = *(const f32x4*)(shp + bj * HALF + 4); }
            float rsv[2][4];
#pragma unroll
            for (int ai = 0; ai < 2; ++ai)
#pragma unroll
                for (int m = 0; m < 4; ++m) rsv[ai][m] = rowss[row0 + ai * HALF + m * 16];
#pragma unroll
            for (int ai = 0; ai < 2; ++ai)
#pragma unroll
                for (int m = 0; m < 4; ++m) { bf16_t* rowp = O + (size_t)(row0 + ai * HALF + m * 16) * ldc + col0;
                    const float rstd = 1.f / sqrtf(rsv[ai][m] * (1.f / D) + EPS);
#pragma unroll
                    for (int bj = 0; bj < 2; ++bj) { f32x4 v0 = acc[ai][bj][m][0] * rstd + sw[bj][0], v1 = acc[ai][bj][m][1] * rstd + sw[bj][1];
                        if (MODE == 1) {
#pragma unroll
                            for (int e = 0; e < 4; ++e) { const float a = fmaxf(v0[e], 0.f), b = fmaxf(v1[e], 0.f); v0[e] = a * a; v1[e] = b * b; } }
                        u32x4 w; w.x = pk2(v0[0], v0[1]); w.y = pk2(v0[2], v0[3]); w.z = pk2(v1[0], v1[1]); w.w = pk2(v1[2], v1[3]);
                        *(u32x4*)(rowp + bj * HALF) = w; } }
        } else if constexpr (MODE == 2) {
            const bool qk = (u.pn < 8), latent = (u.pm >= 32);
            const float scale = (u.pn < 4) ? 0.08838834764831845f : 1.f;
            f32x4 sw[2][2]; float rsv[2][4];
#pragma unroll
            for (int bj = 0; bj < 2; ++bj) { sw[bj][0] = *(const f32x4*)(shp + bj * HALF); sw[bj][1] = *(const f32x4*)(shp + bj * HALF + 4); }
#pragma unroll
            for (int ai = 0; ai < 2; ++ai)
#pragma unroll
                for (int m = 0; m < 4; ++m) rsv[ai][m] = rowss[row0 + ai * HALF + m * 16];
#pragma unroll
            for (int ai = 0; ai < 2; ++ai)
#pragma unroll
                for (int m = 0; m < 4; ++m) { const int r = row0 + ai * HALF + m * 16;
                    const int t = (r - NCTX) & 2047; const int gr = t >> 6, gc = t & 63;
                    const float rstd = 1.f / sqrtf(rsv[ai][m] * (1.f / D) + EPS);
#pragma unroll
                    for (int bj = 0; bj < 2; ++bj) { f32x4 v0 = acc[ai][bj][m][0] * rstd + sw[bj][0], v1 = acc[ai][bj][m][1] * rstd + sw[bj][1];
                        if (qk) {
                            if (latent) {
                                const int c = col0 + bj * HALF;
                                const float pos = (float)(((c >> 6) & 1) ? gc : gr);
                                const int f0 = (c & 63) >> 1;
#pragma unroll
                                for (int pp = 0; pp < 4; ++pp) {
                                    const float ang = pos * __builtin_amdgcn_exp2f(-(float)(f0 + pp) * (13.287712379549449f / 32.f));
                                    const float cs = __cosf(ang), sn = __sinf(ang);
                                    float x1, x2;
                                    if (pp == 0) { x1 = v0[0]; x2 = v0[1]; } else if (pp == 1) { x1 = v0[2]; x2 = v0[3]; } else if (pp == 2) { x1 = v1[0]; x2 = v1[1]; } else { x1 = v1[2]; x2 = v1[3]; }
                                    const float y1 = x1 * cs - x2 * sn, y2 = x1 * sn + x2 * cs;
                                    if (pp == 0) { v0[0] = y1; v0[1] = y2; } else if (pp == 1) { v0[2] = y1; v0[3] = y2; } else if (pp == 2) { v1[0] = y1; v1[1] = y2; } else { v1[2] = y1; v1[3] = y2; }
                                }
                            }
                            v0 = v0 * scale; v1 = v1 * scale;
                        }
                        u32x4 w; w.x = pk2(v0[0], v0[1]); w.y = pk2(v0[2], v0[3]); w.z = pk2(v1[0], v1[1]); w.w = pk2(v1[2], v1[3]);
                        const int c = col0 + bj * HALF; bf16_t* dst;
                        if (c < 2048) { const int hd_ = (c & 1023) >> 7; dst = O + ((size_t)((r >> 8) * 8 + hd_) * 256 + (r & 255)) * QKV_LD + (c >> 10) * 128 + (c & 127); }
                        else if (c < 4096) { const int hd_ = (c - 2048) >> 8; dst = O + ((size_t)((r >> 8) * 8 + hd_) * 256 + (r & 255)) * QKV_LD + 256 + (c & 255); }
                        else dst = O + A_OG / 2 + (size_t)r * 2048 + (c - 4096);
                        *(u32x4*)dst = w; } }
        } else if constexpr (MODE == 3) {
#pragma unroll
            for (int ai = 0; ai < 2; ++ai) {
                u32x4 zwv[4][2];
#pragma unroll
                for (int m = 0; m < 4; ++m)
#pragma unroll
                    for (int bj = 0; bj < 2; ++bj) zwv[m][bj] = *(const u32x4*)(Zp + (size_t)(row0 + ai * HALF + m * 16) * ldz + col0 + bj * HALF);
#pragma unroll
                for (int m = 0; m < 4; ++m) { const int r = row0 + ai * HALF + m * 16;
#pragma unroll
                    for (int bj = 0; bj < 2; ++bj) { const int c = col0 + bj * HALF;
                        const f32x4 b0 = *(const f32x4*)(bias + c), b1 = *(const f32x4*)(bias + c + 4);
                        const u32x4 zw = zwv[m][bj];
                        f32x4 v0 = acc[ai][bj][m][0] + b0, v1 = acc[ai][bj][m][1] + b1;
                        const float z[8] = {bflo(zw.x), bfhi(zw.x), bflo(zw.y), bfhi(zw.y), bflo(zw.z), bfhi(zw.z), bflo(zw.w), bfhi(zw.w)};
#pragma unroll
                        for (int e = 0; e < 4; ++e) { v0[e] = z[e] * sigmoidf_(v0[e]); v1[e] = z[4 + e] * sigmoidf_(v1[e]); }
                        u32x4 w; w.x = pk2(v0[0], v0[1]); w.y = pk2(v0[2], v0[3]); w.z = pk2(v1[0], v1[1]); w.w = pk2(v1[2], v1[3]);
                        *(u32x4*)(O + (size_t)r * ldc + c) = w; } } }
        } else {
            const int rt = u.pm * BM;
            const float* gp = gate + (size_t)cond_of_row(rt) * 6144;
            const float* bp = rt < NCTX ? base0 : base1 - (size_t)NCTX * D;
            const float* gnp = gain ? gain + (size_t)cond_of_row(rt) * D : gp;
            float ssq[2][4];
#pragma unroll
            for (int ai = 0; ai < 2; ++ai)
#pragma unroll
                for (int m = 0; m < 4; ++m) ssq[ai][m] = 0.f;
#pragma unroll
            for (int bj = 0; bj < 2; ++bj) { const int c = col0 + bj * HALF;
                const f32x4 g0 = *(const f32x4*)(gp + c), g1 = *(const f32x4*)(gp + c + 4);
                const f32x4 gn0 = *(const f32x4*)(gnp + c), gn1 = *(const f32x4*)(gnp + c + 4);
#pragma unroll
                for (int ai = 0; ai < 2; ++ai) {
                    f32x4 x0[4], x1[4];
#pragma unroll
                    for (int m = 0; m < 4; ++m) { const size_t off = (size_t)(row0 + ai * HALF + m * 16) * D + c; x0[m] = *(const f32x4*)(bp + off); x1[m] = *(const f32x4*)(bp + off + 4); }
#pragma unroll
                    for (int m = 0; m < 4; ++m) { const size_t off = (size_t)(row0 + ai * HALF + m * 16) * D + c;
                        const f32x4 y0 = x0[m] + g0 * acc[ai][bj][m][0], y1 = x1[m] + g1 * acc[ai][bj][m][1];
                        *(f32x4*)(out + off) = y0; *(f32x4*)(out + off + 4) = y1;
                        ssq[ai][m] += (y0[0] * y0[0] + y0[1] * y0[1]) + (y0[2] * y0[2] + y0[3] * y0[3]) + (y1[0] * y1[0] + y1[1] * y1[1]) + (y1[2] * y1[2] + y1[3] * y1[3]);
                        if (gain) { const f32x4 z0 = y0 * gn0, z1 = y1 * gn1; u32x4 w; w.x = pk2(z0[0], z0[1]); w.y = pk2(z0[2], z0[3]); w.z = pk2(z1[0], z1[1]); w.w = pk2(z1[2], z1[3]); *(u32x4*)(xn + off) = w; } } } }
            const int lane_ = fr + 16 * fq;
#pragma unroll
            for (int ai = 0; ai < 2; ++ai)
#pragma unroll
                for (int m = 0; m < 4; ++m) { float v = ssq[ai][m]; v += shfl_xor_l(v, 16, lane_); v += shfl_xor_l(v, 32, lane_);
                    if (fq == 0) atomicAdd(rowss_out + row0 + ai * HALF + m * 16, v); }
        }
    }
};

template <bool RPERM>
DI void p0_transpose_item(const float* W, int K, int N, bf16_t* WT, LAS float* scr, int item, int lane) {
    const int nblk = N / 32, kb = item / nblk, nb = item % nblk, k0 = 64 * kb, n0 = 32 * nb;
#pragma unroll 8
    for (int i = 0; i < 32; ++i) { const int kk = 2 * i + (lane >> 5); scr[kk * 33 + (lane & 31)] = W[(size_t)(k0 + kk) * N + n0 + (lane & 31)]; }
    LDS_WAIT();
    const int c = lane & 7;
#pragma unroll
    for (int j = 0; j < 4; ++j) { const int n = (lane >> 3) + 8 * j; const LAS float* s = scr + (8 * c) * 33 + n;
        u32x4 o; o.x = pk2(s[0 * 33], s[1 * 33]); o.y = pk2(s[2 * 33], s[3 * 33]); o.z = pk2(s[4 * 33], s[5 * 33]); o.w = pk2(s[6 * 33], s[7 * 33]);
        int nd = n0 + n;
        if (RPERM && nd < 2048) { const int f = nd & 31, s2 = (nd >> 5) & 1; nd = (nd & ~63) + 2 * f + s2; }
        *(u32x4*)(WT + (size_t)nd * K + k0 + 8 * c) = o; }
    LDS_WAIT();
}

DI void p0_prologue(const Args& a, LAS unsigned char* lds, int gw, int NGW, int wave, int lane) {
    LAS float* scr = (LAS float*)(lds + wave * 16384);
    unsigned char* ws = a.ws;
    constexpr int IT_HYIN = (D / 64) * (HY_IN / 32), IT_HYOUT = (D / 64) * (D / 32), IT_GLU = (512 / 64) * (512 / 32), IT_RETIN = (D / 64) * (RET_IN / 32),
                  IT_RETOUT = (2048 / 64) * (D / 32), IT_W1 = (D / 64) * (FF / 32), IT_W2 = (FF / 64) * (D / 32);
    constexpr int NIT = 2 * (IT_HYIN + IT_HYOUT + IT_GLU + IT_RETIN + IT_RETOUT) + 4 * (IT_W1 + IT_W2);
    for (int it = gw; it < NIT; it += NGW) {
        int r = it;
        if (r < 2 * IT_HYIN) { const int j = r / IT_HYIN; p0_transpose_item<false>(a.in[I_HYIN] + (size_t)j * D * HY_IN, D, HY_IN, (bf16_t*)(ws + WS_HYIN) + (size_t)j * D * HY_IN, scr, r % IT_HYIN, lane); continue; } r -= 2 * IT_HYIN;
        if (r < 2 * IT_HYOUT) { const int j = r / IT_HYOUT; p0_transpose_item<false>(a.in[I_HYOUT] + (size_t)j * D * D, D, D, (bf16_t*)(ws + WS_HYOUT) + (size_t)j * D * D, scr, r % IT_HYOUT, lane); continue; } r -= 2 * IT_HYOUT;
        if (r < 2 * IT_GLU) { const int j = r / IT_GLU; p0_transpose_item<false>(a.in[I_GLUW] + (size_t)j * 512 * 512, 512, 512, (bf16_t*)(ws + WS_GLU) + (size_t)j * 512 * 512, scr, r % IT_GLU, lane); continue; } r -= 2 * IT_GLU;
        if (r < 2 * IT_RETIN) { const int j = r / IT_RETIN; p0_transpose_item<true>(a.in[I_RETIN] + (size_t)j * D * RET_IN, D, RET_IN, (bf16_t*)(ws + WS_RETIN) + (size_t)j * D * RET_IN, scr, r % IT_RETIN, lane); continue; } r -= 2 * IT_RETIN;
        if (r < 2 * IT_RETOUT) { const int j = r / IT_RETOUT; p0_transpose_item<false>(a.in[I_RETOUT] + (size_t)j * 2048 * D, 2048, D, (bf16_t*)(ws + WS_RETOUT) + (size_t)j * 2048 * D, scr, r % IT_RETOUT, lane); continue; } r -= 2 * IT_RETOUT;
        if (r < 4 * IT_W1) { const int j = r / IT_W1; p0_transpose_item<false>(a.in[I_W1] + (size_t)j * D * FF, D, FF, (bf16_t*)(ws + WS_W1) + (size_t)j * D * FF, scr, r % IT_W1, lane); continue; } r -= 4 * IT_W1;
        { const int j = r / IT_W2; p0_transpose_item<false>(a.in[I_W2] + (size_t)j * FF * D, FF, D, (bf16_t*)(ws + WS_W2) + (size_t)j * FF * D, scr, r % IT_W2, lane); }
    }
    float* MODP = (float*)(ws + WS_MODP);
    for (int it = gw; it < 16 * 4 * 24; it += NGW) {
        const int nb = it % 24, l = (it / 24) & 3, kc = it / 96, k0 = kc * 64, col0 = nb * 256 + 4 * lane;
        float scv[5];
        { const float v = a.in[I_CCTX][k0 + lane]; scv[0] = siluf_(v); }
#pragma unroll
        for (int cnd = 1; cnd < 5; ++cnd) { const float v = a.in[I_C][(cnd - 1) * D + k0 + lane]; scv[cnd] = siluf_(v); }
        f32x4 acc[5];
#pragma unroll
        for (int cnd = 0; cnd < 5; ++cnd) acc[cnd] = (f32x4){0.f, 0.f, 0.f, 0.f};
        const float* wp = a.in[I_ADAW] + ((size_t)l * D + k0) * 6144 + col0;
#pragma unroll 8
        for (int kk = 0; kk < 64; ++kk) { const f32x4 w4 = *(const f32x4*)(wp + (size_t)kk * 6144);
#pragma unroll
            for (int cnd = 0; cnd < 5; ++cnd) { const float s = __shfl(scv[cnd], kk); acc[cnd] += w4 * s; } }
#pragma unroll
        for (int cnd = 0; cnd < 5; ++cnd) *(f32x4*)(MODP + ((size_t)((kc * 4 + l) * 5 + cnd)) * 6144 + col0) = acc[cnd];
    }
}

DI void norm_row_bf16(const f32x4 (&v)[4], bf16_t* orow, const float* w, const float* sc, const float* sh, int lane) {
    float s = 0.f;
#pragma unroll
    for (int j = 0; j < 4; ++j) { s += (v[j].x * v[j].x + v[j].y * v[j].y) + (v[j].z * v[j].z + v[j].w * v[j].w); }
    const float rstd = 1.f / sqrtf(wave_sum(s, lane) * (1.f / D) + EPS);
    unsigned long long* o8 = (unsigned long long*)orow + lane;
#pragma unroll
    for (int j = 0; j < 4; ++j) { const int c = 4 * lane + 256 * j; const f32x4 ww = *(const f32x4*)(w + c), cc = *(const f32x4*)(sc + c), hh = *(const f32x4*)(sh + c);
        const f32x4 o = v[j] * rstd * ww * (cc + 1.f) + hh;
        o8[64 * j] = (unsigned long long)pk2(o.x, o.y) | ((unsigned long long)pk2(o.z, o.w) << 32); }
}

struct S5C { float are, aim; bf16x8 bfrag[4]; bf16x8 cfrag[4]; };
DI void s5_consts(const Ctx& a, int j, int dir, int g, int lane, S5C& k, bool need_c) {
    const int l32 = lane & 31, h = lane >> 5;
    const int gi = (j * 2 + dir) * 32 + g; const size_t pidx = (size_t)gi * 64;
    const float dt = expf(a.in(I_LOGSTEP)[gi]);
    const float* lamre_ = a.in(I_LAMRE); const float* lamim_ = a.in(I_LAMIM); const float* bre_ = a.in(I_BRE); const float* bim_ = a.in(I_BIM);
#pragma unroll
    for (int pp = 0; pp < 2; ++pp) { const int p = pp * 32 + l32;
        const float lr = lamre_[pidx + p], li = lamim_[pidx + p]; const float mag = expf(lr * dt); const float abr = mag * cosf(li * dt), abi = mag * sinf(li * dt);
        if (pp == h) { k.are = abr; k.aim = abi; }
        const float den = lr * lr + li * li; const float fre = ((abr - 1.f) * lr + abi * li) / den, fim = (abi * lr - (abr - 1.f) * li) / den;
        const f32x4* br = (const f32x4*)(bre_ + (pidx + p) * 16 + 8 * h); const f32x4* bi = (const f32x4*)(bim_ + (pidx + p) * 16 + 8 * h);
        const f32x4 r0 = br[0], r1 = br[1], i0 = bi[0], i1 = bi[1];
        const float bre[8] = {r0.x, r0.y, r0.z, r0.w, r1.x, r1.y, r1.z, r1.w}, bim[8] = {i0.x, i0.y, i0.z, i0.w, i1.x, i1.y, i1.z, i1.w};
#pragma unroll
        for (int i = 0; i < 8; ++i) { k.bfrag[pp][i] = (short)f2bf(fre * bre[i] - fim * bim[i]); k.bfrag[2 + pp][i] = (short)f2bf(fre * bim[i] + fim * bre[i]); } }
    if (need_c) { const int c = lane & 15, kq = lane >> 4;
        const float* cre_ = a.in(I_CRE); const float* cim_ = a.in(I_CIM);
#pragma unroll
        for (int ks = 0; ks < 4; ++ks) { const int p0 = ks * 16 + kq * 4;
            const f32x4 cr = *(const f32x4*)(cre_ + ((size_t)gi * 16 + c) * 64 + p0), ci = *(const f32x4*)(cim_ + ((size_t)gi * 16 + c) * 64 + p0);
            k.cfrag[ks][0] = (short)f2bf(cr.x); k.cfrag[ks][1] = (short)f2bf(-ci.x); k.cfrag[ks][2] = (short)f2bf(cr.y); k.cfrag[ks][3] = (short)f2bf(-ci.y);
            k.cfrag[ks][4] = (short)f2bf(cr.z); k.cfrag[ks][5] = (short)f2bf(-ci.z); k.cfrag[ks][6] = (short)f2bf(cr.w); k.cfrag[ks][7] = (short)f2bf(-ci.w); } }
}
template <bool FULL>
DI void s5_scan256(const S5C& k, int dir, int g, int r0, float& xr, float& xi, LAS unsigned char* wl, const bf16_t* PROJ, float* Y, int lane) {
    const int l32 = lane & 31, h = lane >> 5;
    LAS float* wf = (LAS float*)wl;
    f32x16 zero; for (int i = 0; i < 16; ++i) zero[i] = 0.f;
    auto tok = [&](int s) { return dir ? 255 - s : s; };
    bf16x8 uf = *(const bf16x8*)(PROJ + (size_t)(r0 + tok(l32)) * HY_IN + g * 16 + 8 * h);
    for (int q = 0; q < 8; ++q) {
        bf16x8 ufn = uf;
        if (q < 7) ufn = *(const bf16x8*)(PROJ + (size_t)(r0 + tok(32 * (q + 1) + l32)) * HY_IN + g * 16 + 8 * h);
#pragma unroll
        for (int pp = 0; pp < 2; ++pp) { const f32x16 are_ = MFMA32(uf, k.bfrag[pp], zero), aim_ = MFMA32(uf, k.bfrag[2 + pp], zero);
#pragma unroll
            for (int i = 0; i < 16; ++i) { typedef float f32x2 __attribute__((ext_vector_type(2))); *(LAS f32x2*)(wf + crow(i, h) * 132 + 2 * (pp * 32 + l32)) = (f32x2){are_[i], aim_[i]}; } }
        WAVE_SYNC();
#pragma unroll 1
        for (int m0 = 0; m0 < 32; m0 += 8) {
            typedef float f32x2 __attribute__((ext_vector_type(2)));
            f32x2 b[8];
#pragma unroll
            for (int i = 0; i < 8; ++i) b[i] = *(const LAS f32x2*)(wf + (m0 + i) * 132 + 2 * lane);
            asm volatile("s_waitcnt lgkmcnt(0)" ::: "memory");
#pragma unroll
            for (int i = 0; i < 8; ++i) {
                const float nr = k.are * xr - k.aim * xi + b[i].x, ni = k.are * xi + k.aim * xr + b[i].y; xr = nr; xi = ni;
                if (FULL) *(LAS unsigned*)(wl + (m0 + i) * 528 + 4 * lane) = cvt_pk_bf16(xr, xi);
            }
        }
        if (FULL) {
            WAVE_SYNC();
            const int c = lane & 15, kq = lane >> 4;
#pragma unroll
            for (int tt = 0; tt < 2; ++tt) { f32x4 y = (f32x4){0.f, 0.f, 0.f, 0.f};
#pragma unroll
                for (int ks = 0; ks < 4; ++ks) { const bf16x8 af = *(const LAS bf16x8*)(wl + (tt * 16 + c) * 528 + (ks * 32 + kq * 8) * 2); y = MFMA16(af, k.cfrag[ks], y); }
#pragma unroll
                for (int r = 0; r < 4; ++r) { const int row = r0 + tok(32 * q + tt * 16 + 4 * kq + r); Y[(size_t)row * 512 + g * 16 + c] = y[r]; } }
            WAVE_SYNC();
        }
        uf = ufn;
    }
}
DI void s5_full_dir(const Ctx& a, int j, int sc, int g, int dir, LAS unsigned char* wl, int lane) {
    unsigned char* ws = a.ws(); const bf16_t* PROJ = (const bf16_t*)(ws + WS_A); float* Y = (float*)(ws + WS_A + (dir ? A_YB : A_YF));
    const float* LOC = (const float*)(ws + WS_LOC);
    const int r0 = sc * 256; const bool latent = sc >= 32; const int lb = (sc - 32) >> 3, lc = (sc - 32) & 7;
    S5C k; s5_consts(a, j, dir, g, lane, k, true);
    float xr = 0.f, xi = 0.f;
    if (latent) {
        float pr = k.are, pi = k.aim;
#pragma unroll
        for (int s = 0; s < 8; ++s) { const float t = pr * pr - pi * pi; pi = 2.f * pr * pi; pr = t; }
        const size_t hidx = ((((size_t)lb * 2 + j) * 2 + dir) * 32 + g) * 64 + lane;
        xr = a.in(I_S5RE)[hidx]; xi = a.in(I_S5IM)[hidx];
        typedef float f32x2 __attribute__((ext_vector_type(2)));
        f32x2 lv[7];
#pragma unroll
        for (int q = 0; q < 7; ++q) { const int c2 = dir ? 7 - q : q; lv[q] = *(const f32x2*)(LOC + ((((size_t)(lb * 8 + c2) * 32 + g) * 2 + dir) * 64 + lane) * 2); }
        const int npre = dir ? 7 - lc : lc;
#pragma unroll
        for (int q = 0; q < 7; ++q) if (q < npre) { const float t = pr * xr - pi * xi + lv[q].x; xi = pr * xi + pi * xr + lv[q].y; xr = t; }
    }
    s5_scan256<true>(k, dir, g, r0, xr, xi, wl, PROJ, Y, lane);
    if (!latent) { const size_t oidx = ((((size_t)sc * 2 + j) * 2 + dir) * 32 + g) * 64 + lane; a.out()[O_S5RE + oidx] = xr; a.out()[O_S5IM + oidx] = xi; }
}
DI void s5_combine(const Ctx& a, int j, int sc, int g, int half, int lane) {
    unsigned char* ws = a.ws(); const bf16_t* PROJ = (const bf16_t*)(ws + WS_A); const float* YF = (const float*)(ws + WS_A + A_YF); const float* YB = (const float*)(ws + WS_A + A_YB); bf16_t* Z = (bf16_t*)(ws + WS_A + A_Z);
    const int ch = g * 16 + (lane & 3) * 4; const f32x4 dv = *(const f32x4*)(a.in(I_S5D) + j * 512 + ch);
    f32x4 yfv[8], ybv[8]; u32x2 uwv[8];
#pragma unroll
    for (int it = 0; it < 8; ++it) { const int row = sc * 256 + half * 128 + it * 16 + (lane >> 2);
        yfv[it] = *(const f32x4*)(YF + (size_t)row * 512 + ch); ybv[it] = *(const f32x4*)(YB + (size_t)row * 512 + ch); uwv[it] = *(const u32x2*)(PROJ + (size_t)row * HY_IN + ch); }
#pragma unroll
    for (int it = 0; it < 8; ++it) { const int row = sc * 256 + half * 128 + it * 16 + (lane >> 2);
        const f32x4 yf = yfv[it], yb = ybv[it]; const u32x2 uw = uwv[it];
        const float z0 = gelu_tanh(yf.x + yb.x + dv.x * bflo(uw.x)), z1 = gelu_tanh(yf.y + yb.y + dv.y * bfhi(uw.x)), z2 = gelu_tanh(yf.z + yb.z + dv.z * bflo(uw.y)), z3 = gelu_tanh(yf.w + yb.w + dv.w * bfhi(uw.y));
        u32x2 w; w.x = cvt_pk_bf16(z0, z1); w.y = cvt_pk_bf16(z2, z3); *(u32x2*)(Z + (size_t)row * 512 + ch) = w; }
}
DI void s5_local_unit(const Ctx& a, int j, int lcg, int g, int dir, LAS unsigned char* wl, int lane) {
    unsigned char* ws = a.ws(); const bf16_t* PROJ = (const bf16_t*)(ws + WS_A); float* LOC = (float*)(ws + WS_LOC);
    S5C k; s5_consts(a, j, dir, g, lane, k, false);
    float xr = 0.f, xi = 0.f;
    s5_scan256<false>(k, dir, g, (32 + lcg) * 256, xr, xi, wl, PROJ, nullptr, lane);
    float* lp = LOC + ((((size_t)lcg * 32 + g) * 2 + dir) * 64 + lane) * 2; lp[0] = xr; lp[1] = xi;
}
DI void s5_phase_full(const Ctx& a, int j, int first, LAS unsigned char* wl, int gw, int NGW, int lane) {
    const int ntrip = (2048 + NGW - 1) / NGW;
    for (int tr = 0; tr < ntrip; ++tr) { const int wu = gw + tr * NGW; const bool on = wu < 2048; const int u = wu >> 1, dir = wu & 1;
        if (on) s5_full_dir(a, j, first + (u >> 5), u & 31, dir, wl, lane);
        asm volatile("s_waitcnt vmcnt(0)" ::: "memory"); __syncthreads();
        if (on) s5_combine(a, j, first + (u >> 5), u & 31, dir, lane);
    }
}
DI void conv_part(const Ctx& a, int j, int gtid, int gthreads) {
    unsigned char* ws = a.ws(); const bf16_t* PROJ = (const bf16_t*)(ws + WS_A); bf16_t* MIX = (bf16_t*)(ws + WS_A + A_MIX);
    const float* cw = a.in(I_CONVW) + j * 3 * 512; const float* cb = a.in(I_CONVB) + j * 512;
    const float* cwp = cw; (void)cwp;
    for (int it = gtid; it < NTOK * 64; it += gthreads) {
        const int r = it >> 6, w0 = (it & 63) * 8;
        const int t = r < NCTX ? (r & 255) : ((r - NCTX) & 2047); const int L = r < NCTX ? 256 : 2048;
        float cvm[8], cv0[8], cvp[8];
        auto ldcv = [&](int rr, float (&o)[8], bool valid) {
            if (!valid) { for (int e = 0; e < 8; ++e) o[e] = 0.f; return; }
            const u32x4 cg4 = *(const u32x4*)(PROJ + (size_t)rr * HY_IN + 1024 + w0), v4 = *(const u32x4*)(PROJ + (size_t)rr * HY_IN + 1536 + w0);
            o[0] = bflo(cg4.x) * bflo(v4.x); o[1] = bfhi(cg4.x) * bfhi(v4.x); o[2] = bflo(cg4.y) * bflo(v4.y); o[3] = bfhi(cg4.y) * bfhi(v4.y);
            o[4] = bflo(cg4.z) * bflo(v4.z); o[5] = bfhi(cg4.z) * bfhi(v4.z); o[6] = bflo(cg4.w) * bflo(v4.w); o[7] = bfhi(cg4.w) * bfhi(v4.w); };
        ldcv(r - 1, cvm, t > 0); ldcv(r, cv0, true); ldcv(r + 1, cvp, t < L - 1);
        const u32x4 bg4 = *(const u32x4*)(PROJ + (size_t)r * HY_IN + 512 + w0);
        const float bg[8] = {bflo(bg4.x), bfhi(bg4.x), bflo(bg4.y), bfhi(bg4.y), bflo(bg4.z), bfhi(bg4.z), bflo(bg4.w), bfhi(bg4.w)};
        float o[8];
#pragma unroll
        for (int e = 0; e < 8; ++e) o[e] = bg[e] * (cw[w0 + e] * cvm[e] + cw[512 + w0 + e] * cv0[e] + cw[1024 + w0 + e] * cvp[e] + cb[w0 + e]);
        u32x4 w; w.x = pk2(o[0], o[1]); w.y = pk2(o[2], o[3]); w.z = pk2(o[4], o[5]); w.w = pk2(o[6], o[7]);
        *(u32x4*)(MIX + (size_t)r * D + 512 + w0) = w;
    }
}

constexpr int VT_PITCH = 144, KS_PITCH = 272;
DI int unperm_dk(int dkp) { return (dkp & 64) + ((dkp & 63) >> 1) + 32 * (dkp & 1); }
DI void vt_load(u32x4 (&r)[4], const bf16_t* src, int wave, int lane) {
    const int kp = lane & 31;
#pragma unroll
    for (int it = 0; it < 2; ++it) { const int dg8 = it * 16 + wave * 2 + (lane >> 5);
        r[2 * it] = *(const u32x4*)(src + (size_t)(2 * kp) * QKV_LD + dg8 * 8); r[2 * it + 1] = *(const u32x4*)(src + (size_t)(2 * kp + 1) * QKV_LD + dg8 * 8); }
}
DI void vt_store(LAS unsigned char* VT, const u32x4 (&r)[4], int wave, int lane) {
    const int kp = lane & 31;
#pragma unroll
    for (int it = 0; it < 2; ++it) { const int dg8 = it * 16 + wave * 2 + (lane >> 5);
        LAS unsigned char* dst = VT + (dg8 * 8) * VT_PITCH + kp * 4;
        const unsigned x0[4] = {r[2 * it].x, r[2 * it].y, r[2 * it].z, r[2 * it].w}, x1[4] = {r[2 * it + 1].x, r[2 * it + 1].y, r[2 * it + 1].z, r[2 * it + 1].w};
#pragma unroll
        for (int e = 0; e < 4; ++e) { *(LAS unsigned*)(dst + (2 * e) * VT_PITCH) = (x0[e] & 0xffffu) | (x1[e] << 16); *(LAS unsigned*)(dst + (2 * e + 1) * VT_PITCH) = (x0[e] >> 16) | (x1[e] & 0xffff0000u); } }
}
DI float log2_sigmoid(float x) { return -log2f(1.f + exp2f(-x * 1.4426950408889634f)); }
DI void ret_state_unit(const Ctx& a, int j, int sc, int hd, LAS unsigned char* lds, int wave, int lane) {
    asm volatile("" : "+v"(lane));
    unsigned char* ws = a.ws(); const bf16_t* PROJ = (const bf16_t*)(ws + WS_A);
    const int l32 = lane & 31, h = lane >> 5, r0 = sc * 256;
    const float lgf = log2_sigmoid(a.in(I_GAMMA)[(j * 2 + 0) * 8 + hd]), lgb = log2_sigmoid(a.in(I_GAMMA)[(j * 2 + 1) * 8 + hd]);
    LAS unsigned char* VT = lds; LAS unsigned char* KTf = lds + 36864; LAS unsigned char* KTb = lds + 36864 + 18432;
    f32x16 acc[2][4];
#pragma unroll
    for (int d = 0; d < 2; ++d)
#pragma unroll
        for (int n = 0; n < 4; ++n) for (int i = 0; i < 16; ++i) acc[d][n][i] = 0.f;
    const int kp = lane & 31, dg8k = wave * 2 + (lane >> 5);
    const bf16_t* blk = PROJ + (size_t)(sc * 8 + hd) * 256 * QKV_LD;
    const bf16_t* vsrc = blk + 256; const bf16_t* ksrc = blk + 128 + dg8k * 8;
    u32x4 vr[4], k0r, k1r;
    vt_load(vr, vsrc, wave, lane); k0r = *(const u32x4*)(ksrc + (size_t)(2 * kp) * QKV_LD); k1r = *(const u32x4*)(ksrc + (size_t)(2 * kp + 1) * QKV_LD);
    for (int jb = 0; jb < 4; ++jb) {
        __syncthreads();
        vt_store(VT, vr, wave, lane);
        { const int key = jb * 64 + 2 * kp;
            const float sf0 = __builtin_amdgcn_exp2f(lgf * (float)(255 - key)), sf1 = __builtin_amdgcn_exp2f(lgf * (float)(254 - key)), sb0 = __builtin_amdgcn_exp2f(lgb * (float)key), sb1 = __builtin_amdgcn_exp2f(lgb * (float)(key + 1));
            const unsigned x0[4] = {k0r.x, k0r.y, k0r.z, k0r.w}, x1[4] = {k1r.x, k1r.y, k1r.z, k1r.w};
#pragma unroll
            for (int e = 0; e < 4; ++e) {
                const float k0l = bflo(x0[e]), k0h = bfhi(x0[e]), k1l = bflo(x1[e]), k1h = bfhi(x1[e]);
                const int off = (dg8k * 8 + 2 * e) * VT_PITCH + kp * 4;
                *(LAS unsigned*)(KTf + off) = cvt_pk_bf16(k0l * sf0, k1l * sf1); *(LAS unsigned*)(KTf + off + VT_PITCH) = cvt_pk_bf16(k0h * sf0, k1h * sf1);
                *(LAS unsigned*)(KTb + off) = cvt_pk_bf16(k0l * sb0, k1l * sb1); *(LAS unsigned*)(KTb + off + VT_PITCH) = cvt_pk_bf16(k0h * sb0, k1h * sb1); } }
        __syncthreads();
        if (jb < 3) { vt_load(vr, vsrc + (size_t)(jb + 1) * 64 * QKV_LD, wave, lane);
            k0r = *(const u32x4*)(ksrc + (size_t)((jb + 1) * 64 + 2 * kp) * QKV_LD); k1r = *(const u32x4*)(ksrc + (size_t)((jb + 1) * 64 + 2 * kp + 1) * QKV_LD); }
        bf16x8 fa[2], fb[2][4], fc[2][4];
#define LDST(buf, ks_) do { fa[buf] = *(const LAS bf16x8*)(VT + (32 * wave + l32) * VT_PITCH + ((ks_) * 16 + 8 * h) * 2); _Pragma("unroll") for (int n = 0; n < 4; ++n) { \
            fb[buf][n] = *(const LAS bf16x8*)(KTf + (n * 32 + l32) * VT_PITCH + ((ks_) * 16 + 8 * h) * 2); fc[buf][n] = *(const LAS bf16x8*)(KTb + (n * 32 + l32) * VT_PITCH + ((ks_) * 16 + 8 * h) * 2); } } while (0)
        LDST(0, 0);
#pragma unroll
        for (int ks = 0; ks < 4; ++ks) {
            if (ks < 3) { if (ks & 1) LDST(0, ks + 1); else LDST(1, ks + 1); }
            __builtin_amdgcn_sched_barrier(0);
#pragma unroll
            for (int n = 0; n < 4; ++n) { acc[0][n] = MFMA32(fa[ks & 1], fb[ks & 1][n], acc[0][n]); acc[1][n] = MFMA32(fa[ks & 1], fc[ks & 1][n], acc[1][n]); }
            __builtin_amdgcn_sched_barrier(0); }
#undef LDST
    }
    if (sc < 32) {
#pragma unroll
        for (int d = 0; d < 2; ++d) { float* op = a.out() + O_RET + ((((size_t)sc * 2 + j) * 2 + d) * 8 + hd) * (size_t)(128 * 256);
#pragma unroll
            for (int n = 0; n < 4; ++n) { const int dk = unperm_dk(n * 32 + l32);
#pragma unroll
                for (int g4 = 0; g4 < 4; ++g4) *(f32x4*)(op + (size_t)dk * 256 + 32 * wave + 8 * g4 + 4 * h) = (f32x4){acc[d][n][4 * g4], acc[d][n][4 * g4 + 1], acc[d][n][4 * g4 + 2], acc[d][n][4 * g4 + 3]}; } }
    } else {
        const int lb = (sc - 32) >> 3, lc = (sc - 32) & 7; bf16_t* LOCAL = (bf16_t*)(ws + WS_LOCAL);
#pragma unroll
        for (int d = 0; d < 2; ++d) { bf16_t* op = LOCAL + ((((size_t)lb * 8 + hd) * 8 + lc) * 2 + d) * (size_t)(256 * 128);
#pragma unroll
            for (int n = 0; n < 4; ++n)
#pragma unroll
                for (int r = 0; r < 16; ++r) op[(size_t)(32 * wave + crow(r, h)) * 128 + n * 32 + l32] = (bf16_t)f2bf(acc[d][n][r]); }
    }
}
DI void ret_prefix(const Ctx& a, int j, int gtid, int gthreads) {
    unsigned char* ws = a.ws(); const bf16_t* LOCAL = (const bf16_t*)(ws + WS_LOCAL); bf16_t* SIN = (bf16_t*)(ws + WS_XN);
    for (int it = gtid; it < 4 * 8 * 2 * 4096; it += gthreads) {
        const int e8 = it & 4095, d = (it >> 12) & 1, hd = (it >> 13) & 7, lb = it >> 16;
        const int dv = e8 >> 4, dk0 = (e8 & 15) * 8;
        const float lg = log2_sigmoid(a.in(I_GAMMA)[(j * 2 + d) * 8 + hd]);
        const float cd = exp2f(lg * 256.f);
        const float* s0 = a.in(I_SRET) + ((((size_t)lb * 2 + j) * 2 + d) * 8 + hd) * (size_t)(128 * 256);
        float s[8];
#pragma unroll
        for (int e = 0; e < 8; ++e) s[e] = s0[(size_t)unperm_dk(dk0 + e) * 256 + dv];
        u32x4 lv[8];
#pragma unroll
        for (int cc = 0; cc < 8; ++cc) { const int c = d ? 7 - cc : cc; lv[cc] = *(const u32x4*)(LOCAL + ((((size_t)lb * 8 + hd) * 8 + c) * 2 + d) * (size_t)(256 * 128) + (size_t)dv * 128 + dk0); }
#pragma unroll
        for (int cc = 0; cc < 8; ++cc) { const int c = d ? 7 - cc : cc;
            const size_t blk = ((((size_t)lb * 8 + hd) * 8 + c) * 2 + d) * (size_t)(256 * 128) + (size_t)dv * 128 + dk0;
            u32x4 w; w.x = pk2(s[0], s[1]); w.y = pk2(s[2], s[3]); w.z = pk2(s[4], s[5]); w.w = pk2(s[6], s[7]);
            *(u32x4*)(SIN + blk) = w;
            const u32x4 l4 = lv[cc];
            s[0] = cd * s[0] + bflo(l4.x); s[1] = cd * s[1] + bfhi(l4.x); s[2] = cd * s[2] + bflo(l4.y); s[3] = cd * s[3] + bfhi(l4.y);
            s[4] = cd * s[4] + bflo(l4.z); s[5] = cd * s[5] + bfhi(l4.z); s[6] = cd * s[6] + bflo(l4.w); s[7] = cd * s[7] + bfhi(l4.w); }
    }
}
DI void ret_out_unit(const Ctx& a, int j, int sc, int hd, LAS unsigned char* lds, int wave, int lane, bf16_t* dup_dst = nullptr) {
    asm volatile("v_mbcnt_lo_u32_b32 %0, -1, 0\n\tv_mbcnt_hi_u32_b32 %0, -1, %0" : "=v"(lane));
    unsigned char* ws = a.ws(); bf16_t* PROJ = (bf16_t*)(ws + WS_A);
    const int l32 = lane & 31, h = lane >> 5, r0 = sc * 256, tid = wave * 64 + lane;
    const float lgf = log2_sigmoid(a.in(I_GAMMA)[(j * 2 + 0) * 8 + hd]), lgb = log2_sigmoid(a.in(I_GAMMA)[(j * 2 + 1) * 8 + hd]);
    LAS unsigned char* VT = lds; LAS unsigned char* KS = lds + 36864;
    const int qi = 32 * wave + l32;
    LAS unsigned char* QS = lds + 36864 + 17408;
    const bf16_t* blk = PROJ + (size_t)(sc * 8 + hd) * 256 * QKV_LD;
    __syncthreads();
#pragma unroll
    for (int it = 0; it < 8; ++it) { const int id = tid + it * 512, row = id >> 4, part = id & 15;
        *(LAS u32x4*)(QS + row * KS_PITCH + part * 16) = *(const u32x4*)(blk + (size_t)row * QKV_LD + part * 8); }
    __syncthreads();
    const LAS unsigned char* qrow = QS + qi * KS_PITCH + 16 * h;
#define QF(ks) (*(const LAS bf16x8*)(qrow + (ks) * 32))
    f32x16 acc[8];
#pragma unroll
    for (int t = 0; t < 8; ++t) for (int i = 0; i < 16; ++i) acc[t][i] = 0.f;
    if (sc >= 32) {
        const int lb = (sc - 32) >> 3, lc = (sc - 32) & 7; const bf16_t* SIN = (const bf16_t*)(ws + WS_XN);
        const bf16_t* sf = SIN + ((((size_t)lb * 8 + hd) * 8 + lc) * 2 + 0) * (size_t)(256 * 128); const bf16_t* sb = sf + 256 * 128;
        const float wf_ = __builtin_amdgcn_exp2f(lgf * (float)(qi + 1)), wb_ = __builtin_amdgcn_exp2f(lgb * (float)(256 - qi)); const float ratio = __builtin_amdgcn_exp2f(lgf * (float)(qi + 1) - lgb * (float)(256 - qi));
        bf16x8 qq[8];
#pragma unroll
        for (int ks = 0; ks < 8; ++ks) qq[ks] = QF(ks);
        LAS unsigned char* SS = lds;
        u32x4 sr[4][4];
#pragma unroll
        for (int rd = 0; rd < 4; ++rd) { const bf16_t* sp_ = ((rd & 1) ? sb : sf) + (size_t)(rd >> 1) * 128 * 128;
#pragma unroll
            for (int it = 0; it < 4; ++it) { const int id = tid + it * 512; sr[rd][it] = *(const u32x4*)(sp_ + (size_t)(id >> 4) * 128 + (id & 15) * 8); } }
#pragma unroll
        for (int rd = 0; rd < 4; ++rd) {
            __syncthreads();
#pragma unroll
            for (int it = 0; it < 4; ++it) { const int id = tid + it * 512; *(LAS u32x4*)(SS + (id >> 4) * KS_PITCH + (id & 15) * 16) = sr[rd][it]; }
            __syncthreads();
#pragma unroll
            for (int tt = 0; tt < 4; ++tt) { const int t = (rd >> 1) * 4 + tt;
                bf16x8 af[8];
#pragma unroll
                for (int ks = 0; ks < 8; ++ks) af[ks] = *(const LAS bf16x8*)(SS + (tt * 32 + l32) * KS_PITCH + (ks * 16 + 8 * h) * 2);
                __builtin_amdgcn_sched_barrier(0);
#pragma unroll
                for (int ks = 0; ks < 8; ++ks) acc[t] = MFMA32(af[ks], qq[ks], acc[t]);
                acc[t] = acc[t] * ((rd & 1) ? wb_ : ratio);
                __builtin_amdgcn_sched_barrier(0); }
        }
    }
    const bf16_t* vsrc = blk + 256; const bf16_t* ksrc = blk + (size_t)(tid >> 4) * QKV_LD + 128 + (tid & 15) * 8;
    u32x4 vr[4], kr0, kr1;
    vt_load(vr, vsrc, wave, lane); kr0 = *(const u32x4*)ksrc; kr1 = *(const u32x4*)(ksrc + (size_t)32 * QKV_LD);
    for (int jb = 0; jb < 4; ++jb) {
        __syncthreads();
        vt_store(VT, vr, wave, lane);
        *(LAS u32x4*)(KS + (tid >> 4) * KS_PITCH + (tid & 15) * 16) = kr0; *(LAS u32x4*)(KS + (32 + (tid >> 4)) * KS_PITCH + (tid & 15) * 16) = kr1;
        __syncthreads();
        if (jb < 3) { vt_load(vr, vsrc + (size_t)(jb + 1) * 64 * QKV_LD, wave, lane); kr0 = *(const u32x4*)(ksrc + (size_t)(jb + 1) * 64 * QKV_LD); kr1 = *(const u32x4*)(ksrc + (size_t)((jb + 1) * 64 + 32) * QKV_LD); }
#pragma unroll
        for (int mt = 0; mt < 2; ++mt) {
            f32x16 st; for (int i = 0; i < 16; ++i) st[i] = 0.f;
#pragma unroll
            for (int hf = 0; hf < 2; ++hf) { bf16x8 kf[4], qq[4];
#pragma unroll
                for (int i = 0; i < 4; ++i) { const int ks = hf * 4 + i; kf[i] = *(const LAS bf16x8*)(KS + (mt * 32 + l32) * KS_PITCH + (ks * 16 + 8 * h) * 2); qq[i] = QF(ks); }
                __builtin_amdgcn_sched_barrier(0);
#pragma unroll
                for (int i = 0; i < 4; ++i) st = MFMA32(kf[i], qq[i], st);
                __builtin_amdgcn_sched_barrier(0); }
            bf16x8 vf[8];
#define LDVF(s_, t0_) do { _Pragma("unroll") for (int t = (t0_); t < (t0_) + 4; ++t) { const LAS unsigned char* vp = VT + (t * 32 + l32) * VT_PITCH + (mt * 32 + 16 * (s_) + 4 * h) * 2; \
                const s16x4 lo = *(const LAS s16x4*)vp, hi = *(const LAS s16x4*)(vp + 16); vf[t] = __builtin_shufflevector(lo, hi, 0, 1, 2, 3, 4, 5, 6, 7); } } while (0)
            LDVF(0, 0); LDVF(0, 4);
            __builtin_amdgcn_sched_barrier(0);
#pragma unroll
            for (int r = 0; r < 16; ++r) { const int kj = jb * 64 + mt * 32 + crow(r, h); const int df = qi - kj;
                const float dcy = df == 0 ? 2.f : __builtin_amdgcn_exp2f((df > 0 ? lgf : -lgb) * (float)df); st[r] *= dcy; }
#pragma unroll
            for (int s = 0; s < 2; ++s) {
                u32x4 pw;
                asm volatile("v_cvt_pk_bf16_f32 %0, %4, %5\n\tv_cvt_pk_bf16_f32 %1, %6, %7\n\tv_cvt_pk_bf16_f32 %2, %8, %9\n\tv_cvt_pk_bf16_f32 %3, %10, %11\n\ts_nop 1"
                             : "=&v"(pw[0]), "=&v"(pw[1]), "=&v"(pw[2]), "=&v"(pw[3])
                             : "v"(st[8 * s]), "v"(st[8 * s + 1]), "v"(st[8 * s + 2]), "v"(st[8 * s + 3]), "v"(st[8 * s + 4]), "v"(st[8 * s + 5]), "v"(st[8 * s + 6]), "v"(st[8 * s + 7]));
                const bf16x8 pf = __builtin_bit_cast(bf16x8, pw);
                __builtin_amdgcn_sched_barrier(0);
#pragma unroll
                for (int t = 0; t < 4; ++t) acc[t] = MFMA32(vf[t], pf, acc[t]);
                __builtin_amdgcn_sched_barrier(0);
                if (s == 0) { LDVF(1, 0); __builtin_amdgcn_sched_barrier(0); }
#pragma unroll
                for (int t = 4; t < 8; ++t) acc[t] = MFMA32(vf[t], pf, acc[t]);
                __builtin_amdgcn_sched_barrier(0);
                if (s == 0) { LDVF(1, 4); __builtin_amdgcn_sched_barrier(0); }
            }
#undef LDVF
        }
    }
    float ss = 0.f;
#pragma unroll
    for (int t = 0; t < 8; ++t) for (int i = 0; i < 16; ++i) ss += acc[t][i] * acc[t][i];
    ss += shfl_xor_l(ss, 32, lane);
    const float rstd = 1.f / sqrtf(ss * (1.f / 256.f) + EPS);
    bf16_t* grow = PROJ + A_OG / 2 + (size_t)(r0 + qi) * 2048 + hd * 256; const float* gn = a.in(I_GNW) + j * 2048 + hd * 256;
#pragma unroll
    for (int tb = 0; tb < 8; tb += 2) {
        u32x2 gwv[8]; f32x4 gnv[8];
#pragma unroll
        for (int q = 0; q < 8; ++q) { const int dv0 = 32 * (tb + (q >> 2)) + 8 * (q & 3) + 4 * h; gwv[q] = *(const u32x2*)(grow + dv0); gnv[q] = *(const f32x4*)(gn + dv0); }
#pragma unroll
        for (int q = 0; q < 8; ++q) { const int t = tb + (q >> 2), g4 = q & 3, dv0 = 32 * t + 8 * g4 + 4 * h;
            const float o0 = siluf_(bflo(gwv[q].x)) * acc[t][4 * g4] * rstd * gnv[q].x, o1 = siluf_(bfhi(gwv[q].x)) * acc[t][4 * g4 + 1] * rstd * gnv[q].y,
                        o2 = siluf_(bflo(gwv[q].y)) * acc[t][4 * g4 + 2] * rstd * gnv[q].z, o3 = siluf_(bfhi(gwv[q].y)) * acc[t][4 * g4 + 3] * rstd * gnv[q].w;
            u32x2 w; w.x = cvt_pk_bf16(o0, o1); w.y = cvt_pk_bf16(o2, o3); *(u32x2*)(grow + dv0) = w; }
    }
#undef QF
}


#define XB_TMO      128
#define XB_XCNT(j)  (256  + 64 * (j))
#define XB_XSUB(j)  (1280 + 64 * (j))
#define XB_XGEN(j)  (2304 + 64 * (j))
#define XB_TOP      3328
#define XB_TOPGEN   3392
#define XCD_BAR_WORDS 3456
#define XB_SPIN_CAP (1u << 18)
DI unsigned xb_ld(unsigned* p)              { return __hip_atomic_load(p, __ATOMIC_RELAXED, __HIP_MEMORY_SCOPE_AGENT); }
DI unsigned xb_add(unsigned* p, unsigned v) { return __hip_atomic_fetch_add(p, v, __ATOMIC_RELAXED, __HIP_MEMORY_SCOPE_AGENT); }
DI unsigned xb_xcc_id() { return (unsigned)__builtin_amdgcn_s_getreg((3 << 11) | 20) & 0xFu; }
#define XB_SPIN(cond, bar) do { unsigned _sp = 0; while (cond) { __builtin_amdgcn_s_sleep(1); \
    if ((++_sp & 255u) == 0u) { if (xb_ld(&(bar)[XB_TMO])) break; if (_sp > XB_SPIN_CAP) { atomicAdd(&(bar)[XB_TMO], 1u); break; } } } } while (0)
struct XcdBarrier { unsigned* bar; unsigned x; volatile LAS unsigned* st; };
DI void xcd_barrier_complete(unsigned* bar, unsigned x, unsigned& nloc, unsigned& nx) {
    const unsigned G = gridDim.x * gridDim.y * gridDim.z;
    unsigned sum, cnt, mine, sp = 0u;
    for (;;) {
        sum = 0u; cnt = 0u; mine = 0u;
#pragma unroll
        for (unsigned j = 0; j < 16; ++j) { const unsigned c = xb_ld(&bar[XB_XCNT(j)]); sum += c; cnt += (c > 0u) ? 1u : 0u; mine = (j == x) ? c : mine; }
        if (sum == G) break;
        __builtin_amdgcn_s_sleep(1);
        if ((++sp & 255u) == 0u) { if (xb_ld(&bar[XB_TMO])) break; if (sp > XB_SPIN_CAP) { atomicAdd(&bar[XB_TMO], 1u); break; } }
    }
    nloc = mine > 0u ? mine : 1u; nx = cnt > 0u ? cnt : 1u;
}
DI void xcd_barrier(const XcdBarrier& b) {
    asm volatile("s_waitcnt vmcnt(0)" ::: "memory");
    __syncthreads();
    if (threadIdx.x == 0) {
        unsigned* bar = b.bar;
        __builtin_amdgcn_s_waitcnt(0);
        unsigned nloc = b.st[0], nx = b.st[1];
        if (nloc == 0u) { xcd_barrier_complete(bar, b.x, nloc, nx); b.st[0] = nloc; b.st[1] = nx; }
        const unsigned old = xb_add(&bar[XB_XSUB(b.x)], 1u);
        const unsigned gen = old / nloc;
        if (old + 1u == (gen + 1u) * nloc) {
            __builtin_amdgcn_fence(__ATOMIC_RELEASE, "agent");
            asm volatile("s_waitcnt vmcnt(0)" ::: "memory");
            const unsigned og = xb_add(&bar[XB_TOP], 1u);
            const unsigned tg = og / nx;
            if (og + 1u == (tg + 1u) * nx) xb_add(&bar[XB_TOPGEN], 1u);
            else XB_SPIN(xb_ld(&bar[XB_TOPGEN]) == tg, bar);
            __builtin_amdgcn_fence(__ATOMIC_ACQUIRE, "agent");
            xb_add(&bar[XB_XGEN(b.x)], 1u);
            asm volatile("s_waitcnt vmcnt(0)" ::: "memory");
        } else {
            XB_SPIN(xb_ld(&bar[XB_TOPGEN]) == gen, bar);
            __builtin_amdgcn_fence(__ATOMIC_ACQUIRE, "agent");
            asm volatile("s_waitcnt vmcnt(0)" ::: "memory");
        }
    }
    __syncthreads();
}
constexpr size_t WS_BAR = 65536;
constexpr int LDS_ST_OFF = LDS_BYTES - 64;
__global__ void __launch_bounds__(NWAVES * 64, 2) fwd_kernel(Args a0) {
    extern __shared__ __attribute__((aligned(16))) unsigned char lds_raw[];
    LAS unsigned char* lds = (LAS unsigned char*)lds_raw;
    cg::grid_group grid = cg::this_grid();
    const int tid0 = threadIdx.x;
    const int wave0 = __builtin_amdgcn_readfirstlane(tid0 >> 6);
    const int G = gridDim.x, bx = blockIdx.x;
    const int NGW = G * NWAVES, gthreads = G * NWAVES * 64;
#define FRESH() int lane; asm volatile("v_mbcnt_lo_u32_b32 %0, -1, 0\n\tv_mbcnt_hi_u32_b32 %0, -1, %0" : "=v"(lane)); int wave = wave0; asm volatile("" : "+s"(wave)); const int tid = wave * 64 + lane; \
    const int gw = bx * NWAVES + wave, gtid = bx * (NWAVES * 64) + tid; (void)lane; (void)gw; (void)gtid; \
    const Args* ap_ = (const Args*)a0.ws; asm volatile("" : "+s"(ap_)); Ctx a; a.t = ap_; unsigned char* ws = a.ws(); float* X = a.out(); float* MOD = (float*)(ws + WS_MOD); bf16_t* XN = (bf16_t*)(ws + WS_XN); \
    (void)X; (void)MOD; (void)XN
    if (tid0 < 2) ((volatile LAS unsigned*)(lds + LDS_ST_OFF))[tid0] = 0u;
    __syncthreads();
    if (!MK_MULTI && tid0 == 0) (void)xb_add(&((unsigned*)(a0.ws + WS_BAR))[XB_XCNT(xb_xcc_id())], 1u);
    const int lo = a0.lo, hi = a0.hi;
#ifndef PHASE_MASK
#define PHASE_MASK 0xFFFFFFFFu
#endif
#define KON(kind) (((PHASE_MASK) >> (kind)) & 1u)
#ifndef PROBE_DUP
#define PROBE_DUP 0u
#endif
#define REPS(kind) for (int rep_ = 0; rep_ < ((((PROBE_DUP) >> (kind)) & 1u) ? 2 : 1); ++rep_)
#define RUN(k) (lo <= (k) && (k) < hi)
#define SEAM(k) do { if (RUN(k) && RUN((k) + 1)) { XcdBarrier b_; b_.bar = (unsigned*)(a0.ws + WS_BAR); b_.x = xb_xcc_id(); b_.st = (volatile LAS unsigned*)(lds + LDS_ST_OFF); xcd_barrier(b_); \
        if ((k) == 0 && a0.hi < 0) grid.sync(); } } while (0)

    if (KON(0) && RUN(0)) REPS(0) {
        const int tid = tid0, lane = tid & 63, wave = __builtin_amdgcn_readfirstlane(tid >> 6), gw = bx * NWAVES + wave;
        if (bx == 0 && tid == 0) { Args* t = (Args*)a0.ws;
#pragma unroll
            for (int k = 0; k < 32; ++k) t->in[k] = a0.in[k];
            t->out = a0.out; t->ws = a0.ws; t->lo = 0; t->hi = 0; }
        { float* rs = (float*)(a0.ws + WS_ROWSS); for (int e = bx * (NWAVES * 64) + tid; e < 9 * NTOK; e += gthreads) rs[e] = 0.f; }
        p0_prologue(a0, lds, gw, NGW, wave, lane); }
    SEAM(0);
    if (KON(1) && RUN(1)) REPS(1) { FRESH();
        const float* MODP = (const float*)(ws + WS_MODP);
        for (int e = gtid; e < 4 * 5 * 6144; e += gthreads) { const int l = e / 30720, rem = e % 30720, n = rem % 6144;
            float s = a.in(I_ADAB)[l * 6144 + n];
#pragma unroll
            for (int kc = 0; kc < 16; ++kc) s += MODP[(size_t)kc * (4 * 5 * 6144) + e];
            MOD[e] = s; }
    }
    SEAM(1);
    float* ROWSS = (float*)(a0.ws + WS_ROWSS); float* GAIN = (float*)(a0.ws + WS_GAIN); float* SHW = (float*)(a0.ws + WS_SHW);
    if (KON(2) && RUN(2)) REPS(2) { FRESH();
        { const float* xp_ = a.in(I_XP); const float* xs_ = a.in(I_XS); const float* nw_ = a.in(I_N1W);
            auto rowp = [&](int r) { return r < NCTX ? xp_ + (size_t)r * D : xs_ + (size_t)(r - NCTX) * D; };
            f32x4 cur[4], nxt[4], nwv[4];
#pragma unroll
            for (int q = 0; q < 4; ++q) { cur[q] = ((const f32x4*)rowp(gw) + lane)[64 * q]; nwv[q] = *(const f32x4*)(nw_ + 4 * lane + 256 * q); }
            for (int r = gw; r < NTOK; r += NGW) { const int cnd = cond_of_row(r);
                const int rn = (r + NGW < NTOK) ? r + NGW : r;
#pragma unroll
                for (int q = 0; q < 4; ++q) nxt[q] = ((const f32x4*)rowp(rn) + lane)[64 * q];
                float ss = 0.f; unsigned long long* o8 = (unsigned long long*)(XN + (size_t)r * D) + lane;
#pragma unroll
                for (int q = 0; q < 4; ++q) { const f32x4 v = cur[q]; ss += (v.x * v.x + v.y * v.y) + (v.z * v.z + v.w * v.w);
                    const f32x4 o = v * nwv[q] * (*(const f32x4*)(MOD + cnd * 6144 + 1024 + 4 * lane + 256 * q) + 1.f);
                    o8[64 * q] = (unsigned long long)pk2(o.x, o.y) | ((unsigned long long)pk2(o.z, o.w) << 32); }
                ss = wave_sum(ss, lane); if (lane == 0) ROWSS[r] = ss;
#pragma unroll
                for (int q = 0; q < 4; ++q) cur[q] = nxt[q]; } }
        for (int e = gtid; e < 7 * 5 * D; e += gthreads) { const int n = 1 + e / (5 * D), cnd = (e / D) % 5, col = e % D, li = n >> 1;
            const float wv = (n & 1) ? a.in(I_N2W)[li * D + col] : a.in(I_N1W)[li * D + col];
            GAIN[(size_t)(n * 5 + cnd) * D + col] = wv * (1.f + MOD[(size_t)(li * 5 + cnd) * 6144 + ((n & 1) ? 4096 : 1024) + col]); }
        { const int n = gw & 7, li = n >> 1, jj = li >> 1, wsub = gw >> 3, nsub = NGW >> 3;
            const int N = (n & 1) ? FF : ((li & 1) ? RET_IN : HY_IN);
            const bf16_t* Wt = (n & 1) ? (const bf16_t*)(ws + WS_W1) + (size_t)li * D * FF : ((li & 1) ? (const bf16_t*)(ws + WS_RETIN) + (size_t)jj * D * RET_IN : (const bf16_t*)(ws + WS_HYIN) + (size_t)jj * D * HY_IN);
            const float* shb = MOD + (size_t)li * 5 * 6144 + ((n & 1) ? 3072 : 0) + 16 * lane;
            f32x4 sh[5][4];
#pragma unroll
            for (int cnd = 0; cnd < 5; ++cnd)
#pragma unroll
                for (int q = 0; q < 4; ++q) sh[cnd][q] = *(const f32x4*)(shb + cnd * 6144 + 4 * q);
            for (int c0 = wsub; c0 < N; c0 += 8 * nsub) {
                u32x4 wv[8][2];
#pragma unroll
                for (int cc = 0; cc < 8; ++cc) { const int col = c0 + cc * nsub; const int cl = col < N ? col : c0; wv[cc][0] = *(const u32x4*)(Wt + (size_t)cl * D + 16 * lane); wv[cc][1] = *(const u32x4*)(Wt + (size_t)cl * D + 16 * lane + 8); }
#pragma unroll
                for (int cc = 0; cc < 8; ++cc) { const int col = c0 + cc * nsub; if (col >= N) break;
                    const u32x4 w0 = wv[cc][0], w1 = wv[cc][1];
                    const float wf[16] = {bflo(w0.x), bfhi(w0.x), bflo(w0.y), bfhi(w0.y), bflo(w0.z), bfhi(w0.z), bflo(w0.w), bfhi(w0.w), bflo(w1.x), bfhi(w1.x), bflo(w1.y), bfhi(w1.y), bflo(w1.z), bfhi(w1.z), bflo(w1.w), bfhi(w1.w)};
                    float dsum[5];
#pragma unroll
                    for (int cnd = 0; cnd < 5; ++cnd) { float d = 0.f;
#pragma unroll
                        for (int q = 0; q < 4; ++q) d += (sh[cnd][q].x * wf[4 * q] + sh[cnd][q].y * wf[4 * q + 1]) + (sh[cnd][q].z * wf[4 * q + 2] + sh[cnd][q].w * wf[4 * q + 3]);
                        dsum[cnd] = wave_sum(d, lane); }
                    if (lane == 0) {
#pragma unroll
                        for (int cnd = 0; cnd < 5; ++cnd) SHW[(size_t)(n * 5 + cnd) * 6144 + col] = dsum[cnd]; } } } }
    }
    SEAM(2);
    for (int i = 0; i < DEPTH; ++i) {
        const int pb = 3 + 7 * i, j = i >> 1;
#define modl (MOD + (size_t)i * 5 * 6144)
        if ((i & 1) == 0) {
            if (KON(3) && RUN(pb + 0)) REPS(3) { FRESH(); pg8::Gemm g{XN, (const bf16_t*)(ws + WS_HYIN) + (size_t)j * D * HY_IN, NTOK, HY_IN, D, D}; pg8::StaticOrder S; S.init(NTOK, HY_IN, G, bx);
                Epi<0> E{}; E.O = (bf16_t*)(ws + WS_A); E.ldc = HY_IN; E.rowss = ROWSS + (size_t)(2 * i) * NTOK; E.shw = SHW + (size_t)(2 * i) * 5 * 6144; pg8::gemm_phase(lds, g, S, E, tid); }
            SEAM(pb + 0);
            if (KON(4) && RUN(pb + 1)) REPS(4) { FRESH();
                LAS unsigned char* wl = lds + wave * 16896;
                s5_phase_full(a, j, 0, wl, gw, NGW, lane);
                for (int u = gw; u < 2048; u += NGW) s5_local_unit(a, j, u >> 6, (u >> 1) & 31, u & 1, wl, lane);
                conv_part(a, j, gtid, gthreads);
            }
            SEAM(pb + 1);
            if (KON(5) && RUN(pb + 2)) REPS(5) { FRESH();
                LAS unsigned char* wl = lds + wave * 16896;
                s5_phase_full(a, j, 32, wl, gw, NGW, lane);
            }
            SEAM(pb + 2);
            if (KON(6) && RUN(pb + 3)) REPS(6) { FRESH(); pg8::Gemm g{(const bf16_t*)(ws + WS_A + A_Z), (const bf16_t*)(ws + WS_GLU) + (size_t)j * 512 * 512, NTOK, 512, 512, 512}; pg8::StaticOrder S; S.init(NTOK, 512, G, bx);
                Epi<3> E{}; E.O = (bf16_t*)(ws + WS_A + A_MIX); E.ldc = D; E.bias = a.in(I_GLUB) + j * 512; E.Zp = (const bf16_t*)(ws + WS_A + A_Z); E.ldz = 512; pg8::gemm_phase(lds, g, S, E, tid); }
            SEAM(pb + 3);
            if (KON(7) && RUN(pb + 4)) REPS(7) { FRESH(); pg8::Gemm g{(const bf16_t*)(ws + WS_A + A_MIX), (const bf16_t*)(ws + WS_HYOUT) + (size_t)j * D * D, NTOK, D, D, D}; pg8::StaticOrder S; S.init(NTOK, D, G, bx);
                Epi<4> E{}; E.base0 = (i == 0) ? a.in(I_XP) : X; E.base1 = (i == 0) ? a.in(I_XS) : X + (size_t)NCTX * D; E.out = X; E.gate = modl + 2048;
                E.xn = XN; E.gain = GAIN + (size_t)(2 * i + 1) * 5 * D; E.rowss_out = ROWSS + (size_t)(2 * i + 1) * NTOK; pg8::gemm_phase(lds, g, S, E, tid); }
            SEAM(pb + 4);
        } else {
            if (KON(8) && RUN(pb + 0)) REPS(8) { FRESH(); pg8::Gemm g{XN, (const bf16_t*)(ws + WS_RETIN) + (size_t)j * D * RET_IN, NTOK, RET_IN, D, D}; pg8::StaticOrder S; S.init(NTOK, RET_IN, G, bx);
                Epi<2> E{}; E.O = (bf16_t*)(ws + WS_A); E.ldc = RET_IN; E.rowss = ROWSS + (size_t)(2 * i) * NTOK; E.shw = SHW + (size_t)(2 * i) * 5 * 6144; pg8::gemm_phase(lds, g, S, E, tid); }
            SEAM(pb + 0);
            if (KON(9) && RUN(pb + 1)) REPS(9) { FRESH();
                for (int u = bx; u < 512; u += G) ret_state_unit(a, j, u >> 3, u & 7, lds, wave, lane);
                CFENCE();
                for (int u = bx; u < 256; u += G) ret_out_unit(a, j, u >> 3, u & 7, lds, wave, lane);
            }
            SEAM(pb + 1);
            if (KON(10) && RUN(pb + 2)) REPS(10) { FRESH(); ret_prefix(a, j, gtid, gthreads); }
            SEAM(pb + 2);
            if (KON(11) && RUN(pb + 3)) REPS(11) { FRESH(); for (int u = bx; u < 256; u += G) ret_out_unit(a, j, 32 + (u >> 3), u & 7, lds, wave, lane); }
            SEAM(pb + 3);
            if (KON(12) && RUN(pb + 4)) REPS(12) { FRESH(); pg8::Gemm g{(const bf16_t*)(ws + WS_A + A_OG), (const bf16_t*)(ws + WS_RETOUT) + (size_t)j * 2048 * D, NTOK, D, 2048, 2048}; pg8::StaticOrder S; S.init(NTOK, D, G, bx);
                Epi<4> E{}; E.base0 = X; E.base1 = X + (size_t)NCTX * D; E.out = X; E.gate = modl + 2048;
                E.xn = XN; E.gain = GAIN + (size_t)(2 * i + 1) * 5 * D; E.rowss_out = ROWSS + (size_t)(2 * i + 1) * NTOK; pg8::gemm_phase(lds, g, S, E, tid); }
            SEAM(pb + 4);
        }
        if (KON(13) && RUN(pb + 5)) REPS(13) { FRESH(); pg8::Gemm g{XN, (const bf16_t*)(ws + WS_W1) + (size_t)i * D * FF, NTOK, FF, D, D}; pg8::StaticOrder S; S.init(NTOK, FF, G, bx);
            Epi<1> E{}; E.O = (bf16_t*)(ws + WS_A); E.ldc = FF; E.rowss = ROWSS + (size_t)(2 * i + 1) * NTOK; E.shw = SHW + (size_t)(2 * i + 1) * 5 * 6144; pg8::gemm_phase(lds, g, S, E, tid); }
        SEAM(pb + 5);
        if (KON(14) && RUN(pb + 6)) REPS(14) { FRESH(); pg8::Gemm g{(const bf16_t*)(ws + WS_A), (const bf16_t*)(ws + WS_W2) + (size_t)i * FF * D, NTOK, D, FF, FF}; pg8::StaticOrder S; S.init(NTOK, D, G, bx);
            Epi<4> E{}; E.base0 = X; E.base1 = X + (size_t)NCTX * D; E.out = X; E.gate = modl + 5120;
            E.xn = XN; E.gain = (i < DEPTH - 1) ? GAIN + (size_t)(2 * i + 2) * 5 * D : nullptr; E.rowss_out = ROWSS + (size_t)(2 * i + 2) * NTOK; pg8::gemm_phase(lds, g, S, E, tid); }
        SEAM(pb + 6);
    }
    if (KON(15) && RUN(31)) REPS(15) { FRESH();
        const float* fw = a.in(I_FNW);
        f32x4 fwv[4], v[4], nxt[4];
#pragma unroll
        for (int q = 0; q < 4; ++q) { fwv[q] = *(const f32x4*)(fw + 4 * lane + 256 * q); v[q] = ((const f32x4*)(X + (size_t)gw * D) + lane)[64 * q]; }
        for (int r = gw; r < NTOK; r += NGW) {
            f32x4* xr = (f32x4*)(X + (size_t)r * D) + lane;
            const int rn = (r + NGW < NTOK) ? r + NGW : r;
#pragma unroll
            for (int q = 0; q < 4; ++q) nxt[q] = ((const f32x4*)(X + (size_t)rn * D) + lane)[64 * q];
            const float rstd = 1.f / sqrtf(ROWSS[(size_t)8 * NTOK + r] * (1.f / D) + EPS);
#pragma unroll
            for (int q = 0; q < 4; ++q) xr[64 * q] = v[q] * rstd * fwv[q];
#pragma unroll
            for (int q = 0; q < 4; ++q) v[q] = nxt[q];
        }
    }
#undef RUN
#undef modl
#undef FRESH
#undef KON
#undef SEAM
}
constexpr int N_PHASES = 32;

extern "C" void kernel_launch(void* const* d_in, const int* in_sizes, int n_in, void* d_out, int out_size, void* d_ws, size_t ws_size, hipStream_t stream) {
    static int grid = 0;
    if (grid == 0) {
        if (n_in != 32 || ws_size < WS_END) { fprintf(stderr, "kernel_launch: unexpected n_in %d / ws_size %zu\n", n_in, ws_size); grid = -1; return; }
        int dev = 0, cus = 0, per_cu = 0;
        (void)hipGetDevice(&dev); (void)hipDeviceGetAttribute(&cus, hipDeviceAttributeMultiprocessorCount, dev);
        if (hipFuncSetAttribute((const void*)fwd_kernel, hipFuncAttributeMaxDynamicSharedMemorySize, LDS_BYTES) != hipSuccess) { fprintf(stderr, "kernel_launch: hipFuncSetAttribute failed\n"); grid = -1; return; }
        (void)hipOccupancyMaxActiveBlocksPerMultiprocessor(&per_cu, (const void*)fwd_kernel, NWAVES * 64, LDS_BYTES);
        (void)hipGetLastError();
        if (per_cu < 1) fprintf(stderr, "kernel_launch: occupancy query says %d\n", per_cu);
        grid = cus > 0 ? cus : 256;
    }
    if (grid < 0) return;
    Args a{};
    for (int i = 0; i < 32; ++i) a.in[i] = (const float*)d_in[i];
    a.out = (float*)d_out; a.ws = (unsigned char*)d_ws;
#if MK_MULTI
    for (int p = 0; p < N_PHASES; ++p) { a.lo = p; a.hi = p + 1; hipLaunchKernelGGL(fwd_kernel, dim3(grid), dim3(NWAVES * 64), LDS_BYTES, stream, a); }
#else
    a.lo = 0; a.hi = N_PHASES;
    if (hipMemsetAsync((char*)d_ws + WS_BAR, 0, XCD_BAR_WORDS * 4, stream) != hipSuccess) { fprintf(stderr, "kernel_launch: memset failed\n"); return; }
    void* args[] = {&a};
    hipError_t e = hipLaunchCooperativeKernel((const void*)fwd_kernel, dim3(grid), dim3(NWAVES * 64), args, LDS_BYTES, stream);
    if (e != hipSuccess) fprintf(stderr, "cooperative launch failed: %s (grid %d)\n", hipGetErrorString(e), grid);
#endif
}
```

```cpp
#include <hip/hip_runtime.h>
#include <hip/hip_cooperative_groups.h>
#include <cstdio>
#include <cstdint>
namespace cg = cooperative_groups;

#ifndef MK_MULTI
#define MK_MULTI 0
#endif

#define DI __device__ __forceinline__
#define LAS __attribute__((address_space(3)))
typedef unsigned short bf16_t;
typedef short bf16x8 __attribute__((ext_vector_type(8)));
typedef short s16x4 __attribute__((ext_vector_type(4)));
typedef float f32x4 __attribute__((ext_vector_type(4)));
typedef float f32x16 __attribute__((ext_vector_type(16)));
typedef unsigned u32x4 __attribute__((ext_vector_type(4)));
typedef unsigned u32x2 __attribute__((ext_vector_type(2)));

constexpr int D = 1024, NTOK = 16384, NCTX = 8192, DEPTH = 4;
constexpr int HY_IN = 2048, RET_IN = 6144, FF = 4096;
constexpr float EPS = 1e-6f;
constexpr int NWAVES = 8;
constexpr int LDS_BYTES = 147456;
enum { I_XP = 0, I_XS, I_S5RE, I_S5IM, I_SRET, I_C, I_CCTX, I_N1W, I_N2W, I_ADAW, I_ADAB, I_HYIN, I_HYOUT, I_LAMRE, I_LAMIM, I_LOGSTEP,
       I_BRE, I_BIM, I_CRE, I_CIM, I_S5D, I_GLUW, I_GLUB, I_CONVW, I_CONVB, I_RETIN, I_RETOUT, I_GAMMA, I_GNW, I_W1, I_W2, I_FNW };
constexpr size_t O_S5RE = 16777216, O_S5IM = 16777216 + 262144, O_RET = 16777216 + 2 * 262144;
constexpr size_t MiB = 1u << 20;
constexpr size_t WS_MODP = 1 * MiB, WS_MOD = 9 * MiB, WS_LOC = 10 * MiB;
constexpr size_t WS_ROWSS = 377 * MiB, WS_GAIN = 378 * MiB, WS_SHW = 379 * MiB;

constexpr size_t WS_HYIN = 12 * MiB, WS_HYOUT = 20 * MiB, WS_GLU = 24 * MiB, WS_RETIN = 25 * MiB, WS_RETOUT = 49 * MiB, WS_W1 = 57 * MiB, WS_W2 = 89 * MiB;
constexpr size_t WS_XN = 121 * MiB, WS_A = 153 * MiB, WS_LOCAL = 345 * MiB, WS_END = 380 * MiB;
constexpr size_t A_YF = 64 * MiB, A_Z = 96 * MiB, A_MIX = 112 * MiB, A_YB = 144 * MiB, A_UB = 176 * MiB;
constexpr size_t A_OG = 128 * MiB;
constexpr int QKV_LD = 512;

struct Args { const float* in[32]; float* out; unsigned char* ws; int lo, hi; };
struct Ctx { const Args* t;
    __device__ __forceinline__ const float* in(int k) const { unsigned long long r; asm volatile("s_load_dwordx2 %0, %1, %2\n\ts_waitcnt lgkmcnt(0)" : "=s"(r) : "s"(t), "s"(k * 8) : "memory"); return (const float*)(const __attribute__((address_space(1))) float*)r; }
    __device__ __forceinline__ float* out() const { unsigned long long r; asm volatile("s_load_dwordx2 %0, %1, 0x100\n\ts_waitcnt lgkmcnt(0)" : "=s"(r) : "s"(t) : "memory"); return (float*)(__attribute__((address_space(1))) float*)r; }
    __device__ __forceinline__ unsigned char* ws() const { return (unsigned char*)(__attribute__((address_space(1))) unsigned char*)(unsigned long long)t; } };

typedef float f32x2_ __attribute__((ext_vector_type(2)));
typedef __bf16 bf16x2_ __attribute__((ext_vector_type(2)));
DI unsigned pk2(float lo, float hi) { const f32x2_ v = {lo, hi}; return __builtin_bit_cast(unsigned, __builtin_convertvector(v, bf16x2_)); }
DI unsigned f2bf(float f) { return pk2(f, 0.f) & 0xffffu; }
DI unsigned cvt_pk_bf16(float lo, float hi) { unsigned r; asm volatile("v_cvt_pk_bf16_f32 %0, %1, %2" : "=v"(r) : "v"(lo), "v"(hi)); return r; }
DI float bf2f(unsigned b) { return __builtin_bit_cast(float, b << 16); }
DI float bflo(unsigned w) { return __builtin_bit_cast(float, w << 16); }
DI float bfhi(unsigned w) { return __builtin_bit_cast(float, w & 0xffff0000u); }
DI float shfl_xor_l(float v, int o, int lane) { return __builtin_bit_cast(float, __builtin_amdgcn_ds_bpermute((lane ^ o) << 2, __builtin_bit_cast(int, v))); }
DI float wave_sum(float v, int lane) {
#pragma unroll
    for (int o = 1; o < 64; o <<= 1) v += shfl_xor_l(v, o, lane);
    return v;
}
DI int crow(int reg, int h) { return (reg & 3) + 8 * (reg >> 2) + 4 * h; }
DI float sigmoidf_(float x) { return __builtin_amdgcn_rcpf(1.f + __expf(-x)); }
DI float siluf_(float x) { return x * sigmoidf_(x); }
DI float gelu_tanh(float x) { const float u = 0.7978845608028654f * (x + 0.044715f * x * x * x); const float e = __expf(2.f * u); return x * (1.f - __builtin_amdgcn_rcpf(e + 1.f)); }
DI int cond_of_row(int r) { return r < NCTX ? 0 : 1 + ((r - NCTX) >> 11); }
#define MFMA32(a, b, c) __builtin_amdgcn_mfma_f32_32x32x16_bf16((a), (b), (c), 0, 0, 0)
#define MFMA16(a, b, c) __builtin_amdgcn_mfma_f32_16x16x32_bf16((a), (b), (c), 0, 0, 0)
#define LDS_WAIT() asm volatile("s_waitcnt lgkmcnt(0)" ::: "memory")
#define CFENCE() do { asm volatile("" ::: "memory"); __builtin_amdgcn_sched_barrier(0); } while (0)
#define WAVE_SYNC() do { asm volatile("s_waitcnt lgkmcnt(0)" ::: "memory"); __builtin_amdgcn_wave_barrier(); } while (0)

namespace pg8 {
constexpr int BM = 256, BK = 64, HALF = 128, HTB = HALF * BK * 2, STAGE_BYTES = 8 * HTB, NXCD = 8, WGM = 8;
DI int lds_byte(int r, int c) { const int st = (r >> 4) * 2 + (c >> 5), rr = r & 15, cc = c & 31, ob = rr * 64 + cc * 2; return st * 1024 + (ob ^ (((ob >> 9) & 1) << 5)); }
DI void stage_rc(int b, int& R, int& C) { const int st = b / 1024, sb = b % 1024, swz = sb ^ (((sb >> 9) & 1) << 5); R = (st >> 1) * 16 + swz / 64; C = (st & 1) * 32 + (swz % 64) / 2; }
DI int perm32(int rho) { const int n = rho >> 4, i = rho & 15; return 8 * (i >> 2) + 4 * n + (i & 3); }
struct Unit { int pm, pn; };
struct Gemm { const bf16_t* A; const bf16_t* Bt; int M, N, K, lda; };
struct StaticOrder {
    int nM, nN, nwg, G, c;
    DI void init(int M, int N, int G_, int c_) { nM = M / BM; nN = N / BM; nwg = nM * nN; G = G_; c = c_; }
    DI bool next(int i, Unit& u) const {
        const long L = (long)i * G + c; if (L >= nwg) return false;
        int wgid = (int)L; { const int q = nwg / NXCD, r = nwg % NXCD, xcd = wgid % NXCD, off = wgid / NXCD; wgid = (xcd < r ? xcd * (q + 1) : r * (q + 1) + (xcd - r) * q) + off; }
        const int nig = WGM * nN, gid = wgid / nig, fm = gid * WGM, gsz = (nM - fm) < WGM ? (nM - fm) : WGM;
        u.pm = fm + ((wgid % nig) % gsz); u.pn = (wgid % nig) / gsz; return true;
    }
};
template <class Epi>
DI void gemm_phase(LAS unsigned char* lds, const Gemm g, const StaticOrder& S, const Epi& E, const int tid) {
    const int wid = __builtin_amdgcn_readfirstlane(tid >> 6), lane = tid & 63, wr = wid >> 2, wc = wid & 3, fr = lane & 15, fq = lane >> 4;
    const int K = g.K, nt = K / BK, lda = g.lda;
    unsigned voffA[2], voffB[2];
#pragma unroll
    for (int i = 0; i < 2; ++i) { int R, C; stage_rc(tid * 16 + i * 8192, R, C); const int Rb = (R & ~31) + perm32(R & 31);
        voffA[i] = (unsigned)(R * lda + C) * 2u; voffB[i] = (unsigned)(Rb * K + C) * 2u; }
    const size_t kstep = (size_t)(BK * 2);
    const size_t hstepA = (size_t)HALF * lda * 2, hstepB = (size_t)HALF * K * 2;
    const size_t tstepA = 2 * hstepA, tstepB = 2 * hstepB;
    const unsigned ldsw = (unsigned)wid * 1024u;
    const int aoff = lds_byte(wr * 64 + fr, fq * 8), boff = lds_byte(wc * 32 + fr, fq * 8);
#define PG8_SA(b, h) (((b) * 2 + (h)) * HTB)
#define PG8_SB(b, h) ((4 + (b) * 2 + (h)) * HTB)
#define PG8_STAGE(bufoff, gbase, voff) do { _Pragma("unroll") for (int _i = 0; _i < 2; ++_i) \
        __builtin_amdgcn_global_load_lds((const unsigned*)((const char*)(gbase) + (voff)[_i]), (LAS unsigned*)(lds + (bufoff) + ldsw + _i * 8192), 16, 0, 0); } while (0)
#define PG8_LDA(dst, b, h) do { _Pragma("unroll") for (int m = 0; m < 4; ++m) _Pragma("unroll") for (int k = 0; k < 2; ++k) dst[m][k] = *(const LAS bf16x8*)(lds + PG8_SA(b, h) + aoff + m * 2048 + k * 1024); } while (0)
#define PG8_LDB(dst, b, h) do { _Pragma("unroll") for (int n = 0; n < 2; ++n) _Pragma("unroll") for (int k = 0; k < 2; ++k) dst[n][k] = *(const LAS bf16x8*)(lds + PG8_SB(b, h) + boff + n * 2048 + k * 1024); } while (0)
#define PG8_MMA(ai, bj, At, Bt) do { __builtin_amdgcn_s_setprio(1); _Pragma("unroll") for (int m = 0; m < 4; ++m) _Pragma("unroll") for (int n = 0; n < 2; ++n) _Pragma("unroll") for (int k = 0; k < 2; ++k) \
        acc[ai][bj][m][n] = __builtin_amdgcn_mfma_f32_16x16x32_bf16(Bt[n][k], At[m][k], acc[ai][bj][m][n], 0, 0, 0); __builtin_amdgcn_s_setprio(0); } while (0)
#define PG8_WAIT_V(n) asm volatile("s_waitcnt vmcnt(" #n ")" ::: "memory")
#define PG8_WAIT_L(n) asm volatile("s_waitcnt lgkmcnt(" #n ")" ::: "memory")
#define PG8_BAR __builtin_amdgcn_s_barrier()
#define PG8_SCHED __builtin_amdgcn_sched_barrier(0)
    Unit cur, nxt; int ui = 0;
    if (!S.next(0, cur)) return;
    f32x4 acc[2][2][4][2];
#pragma unroll
    for (int a = 0; a < 2; ++a)
#pragma unroll
        for (int b = 0; b < 2; ++b)
#pragma unroll
            for (int m = 0; m < 4; ++m)
#pragma unroll
                for (int n = 0; n < 2; ++n) acc[a][b][m][n] = (f32x4){0.f, 0.f, 0.f, 0.f};
    bf16x8 At[4][2], B0[2][2], B1[2][2];
    const char* cA = (const char*)g.A + (size_t)cur.pm * tstepA; const char* cB = (const char*)g.Bt + (size_t)cur.pn * tstepB;
    PG8_STAGE(PG8_SB(0, 0), cB, voffB); PG8_STAGE(PG8_SB(0, 1), cB + hstepB, voffB); PG8_STAGE(PG8_SA(0, 0), cA, voffA); PG8_STAGE(PG8_SA(0, 1), cA + hstepA, voffA);
    if (wr == 1) PG8_BAR;
    PG8_WAIT_V(2); PG8_BAR;
    PG8_STAGE(PG8_SB(1, 0), cB + kstep, voffB); PG8_STAGE(PG8_SA(1, 0), cA + kstep, voffA); PG8_STAGE(PG8_SB(1, 1), cB + hstepB + kstep, voffB);
    PG8_WAIT_V(6); PG8_BAR;
    for (;;) {
        const bool has_next = S.next(ui + 1, nxt);
        const char* nA = has_next ? (const char*)g.A + (size_t)nxt.pm * tstepA : cA; const char* nB = has_next ? (const char*)g.Bt + (size_t)nxt.pn * tstepB : cB;
        for (int t = 0; t < nt; t += 2) {
            const bool last = (t == nt - 2);
            const char* a1 = cA + (size_t)(t + 1) * kstep;
            const char* a2 = last ? nA : cA + (size_t)(t + 2) * kstep; const char* b2 = last ? nB : cB + (size_t)(t + 2) * kstep;
            const char* a3 = a2 + kstep; const char* b3 = b2 + kstep;
            PG8_LDB(B0, 0, 0); PG8_LDB(B1, 0, 1); PG8_SCHED; PG8_LDA(At, 0, 0); PG8_STAGE(PG8_SA(1, 1), a1 + hstepA, voffA);
            PG8_WAIT_V(8); PG8_WAIT_L(0); PG8_BAR; PG8_MMA(0, 0, At, B0); PG8_MMA(0, 1, At, B1); PG8_BAR; PG8_SCHED;
            PG8_LDA(At, 0, 1); PG8_STAGE(PG8_SB(0, 0), b2, voffB); PG8_STAGE(PG8_SB(0, 1), b2 + hstepB, voffB); PG8_STAGE(PG8_SA(0, 0), a2, voffA);
            PG8_WAIT_V(8); PG8_WAIT_L(0); PG8_BAR; PG8_MMA(1, 0, At, B0); PG8_MMA(1, 1, At, B1); PG8_BAR; PG8_SCHED;
            PG8_LDB(B0, 1, 0); PG8_LDB(B1, 1, 1); PG8_SCHED; PG8_LDA(At, 1, 0); PG8_STAGE(PG8_SA(0, 1), a2 + hstepA, voffA);
            PG8_WAIT_V(8); PG8_WAIT_L(0); PG8_BAR; PG8_MMA(0, 0, At, B0); PG8_MMA(0, 1, At, B1); PG8_BAR; PG8_SCHED;
            PG8_LDA(At, 1, 1); PG8_STAGE(PG8_SB(1, 0), b3, voffB); PG8_STAGE(PG8_SB(1, 1), b3 + hstepB, voffB); PG8_STAGE(PG8_SA(1, 0), a3, voffA);
            PG8_WAIT_V(8); PG8_WAIT_L(0); PG8_BAR; PG8_MMA(1, 0, At, B0); PG8_MMA(1, 1, At, B1); PG8_BAR; PG8_SCHED;
        }
        if (wr == 0) PG8_BAR;
        E(acc, cur, wr, wc, fr, fq);
        if (!has_next) break;
#pragma unroll
        for (int a = 0; a < 2; ++a)
#pragma unroll
            for (int b = 0; b < 2; ++b)
#pragma unroll
                for (int m = 0; m < 4; ++m)
#pragma unroll
                    for (int n = 0; n < 2; ++n) acc[a][b][m][n] = (f32x4){0.f, 0.f, 0.f, 0.f};
        cur = nxt; cA = nA; cB = nB; ++ui;
        if (wr == 1) PG8_BAR;
    }
    PG8_WAIT_V(0);
    PG8_BAR;
#undef PG8_SA
#undef PG8_SB
#undef PG8_STAGE
#undef PG8_LDA
#undef PG8_LDB
#undef PG8_MMA
#undef PG8_WAIT_V
#undef PG8_WAIT_L
#undef PG8_BAR
#undef PG8_SCHED
}
}

template <int MODE> struct Epi {
    bf16_t* O; int ldc;
    const float* rowss; const float* shw;
    bf16_t* xn; const float* gain; float* rowss_out;
    const float* bias; const bf16_t* Zp; int ldz;
    const float* base0; const float* base1; float* out; const float* gate;
    DI void operator()(const f32x4 (&acc)[2][2][4][2], const pg8::Unit& u, int wr, int wc, int fr, int fq) const {
        using namespace pg8;
        const int row0 = u.pm * BM + wr * 64 + fr, col0 = u.pn * BM + wc * 32 + 8 * fq;
        const float* shp = shw + (size_t)cond_of_row(u.pm * BM) * 6144 + col0;
        if constexpr (MODE == 0 || MODE == 1) {
            f32x4 sw[2][2];
#pragma unroll
            for (int bj = 0; bj < 2; ++bj) { sw[bj][0] = *(const f32x4*)(shp + bj * HALF); sw[bj][1] = *(const f32x4*)(shp + bj * HALF + 4); }
            float rsv[2][4];
#pragma unroll
            for (int ai = 0; ai < 2; ++ai)
#pragma unroll
                for (int m = 0; m < 4; ++m) rsv[ai][m] = rowss[row0 + ai * HALF + m * 16];
#pragma unroll
            for (int ai = 0; ai < 2; ++ai)
#pragma unroll
                for (int m = 0; m < 4; ++m) { bf16_t* rowp = O + (size_t)(row0 + ai * HALF + m * 16) * ldc + col0;
                    const float rstd = 1.f / sqrtf(rsv[ai][m] * (1.f / D) + EPS);
#pragma unroll
                    for (int bj = 0; bj < 2; ++bj) { f32x4 v0 = acc[ai][bj][m][0] * rstd + sw[bj][0], v1 = acc[ai][bj][m][1] * rstd + sw[bj][1];
                        if (MODE == 1) {
#pragma unroll
                            for (int e = 0; e < 4; ++e) { const float a = fmaxf(v0[e], 0.f), b = fmaxf(v1[e], 0.f); v0[e] = a * a; v1[e] = b * b; } }
                        u32x4 w; w.x = pk2(v0[0], v0[1]); w.y = pk2(v0[2], v0[3]); w.z = pk2(v1[0], v1[1]); w.w = pk2(v1[2], v1[3]);
                        *(u32x4*)(rowp + bj * HALF) = w; } }
        } else if constexpr (MODE == 2) {
            const bool qk = (u.pn < 8), latent = (u.pm >= 32);
            const float scale = (u.pn < 4) ? 0.08838834764831845f : 1.f;
            f32x4 sw[2][2]; float rsv[2][4];
#pragma unroll
            for (int bj = 0; bj < 2; ++bj) { sw[bj][0] = *(const f32x4*)(shp + bj * HALF); sw[bj][1] = *(const f32x4*)(shp + bj * HALF + 4); }
#pragma unroll
            for (int ai = 0; ai < 2; ++ai)
#pragma unroll
                for (int m = 0; m < 4; ++m) rsv[ai][m] = rowss[row0 + ai * HALF + m * 16];
#pragma unroll
            for (int ai = 0; ai < 2; ++ai)
#pragma unroll
                for (int m = 0; m < 4; ++m) { const int r = row0 + ai * HALF + m * 16;
                    const int t = (r - NCTX) & 2047; const int gr = t >> 6, gc = t & 63;
                    const float rstd = 1.f / sqrtf(rsv[ai][m] * (1.f / D) + EPS);
#pragma unroll
                    for (int bj = 0; bj < 2; ++bj) { f32x4 v0 = acc[ai][bj][m][0] * rstd + sw[bj][0], v1 = acc[ai][bj][m][1] * rstd + sw[bj][1];
                        if (qk) {
                            if (latent) {
                                const int c = col0 + bj * HALF;
                                const float pos = (float)(((c >> 6) & 1) ? gc : gr);
                                const int f0 = (c & 63) >> 1;
#pragma unroll
                                for (int pp = 0; pp < 4; ++pp) {
                                    const float ang = pos * __builtin_amdgcn_exp2f(-(float)(f0 + pp) * (13.287712379549449f / 32.f));
                                    const float cs = __cosf(ang), sn = __sinf(ang);
                                    float x1, x2;
                                    if (pp == 0) { x1 = v0[0]; x2 = v0[1]; } else if (pp == 1) { x1 = v0[2]; x2 = v0[3]; } else if (pp == 2) { x1 = v1[0]; x2 = v1[1]; } else { x1 = v1[2]; x2 = v1[3]; }
                                    const float y1 = x1 * cs - x2 * sn, y2 = x1 * sn + x2 * cs;
                                    if (pp == 0) { v0[0] = y1; v0[1] = y2; } else if (pp == 1) { v0[2] = y1; v0[3] = y2; } else if (pp == 2) { v1[0] = y1; v1[1] = y2; } else { v1[2] = y1; v1[3] = y2; }
                                }
                            }
                            v0 = v0 * scale; v1 = v1 * scale;
                        }
                        u32x4 w; w.x = pk2(v0[0], v0[1]); w.y = pk2(v0[2], v0[3]); w.z = pk2(v1[0], v1[1]); w.w = pk2(v1[2], v1[3]);
                        const int c = col0 + bj * HALF; bf16_t* dst;
                        if (c < 2048) { const int hd_ = (c & 1023) >> 7; dst = O + ((size_t)((r >> 8) * 8 + hd_) * 256 + (r & 255)) * QKV_LD + (c >> 10) * 128 + (c & 127); }
                        else if (c < 4096) { const int hd_ = (c - 2048) >> 8; dst = O + ((size_t)((r >> 8) * 8 + hd_) * 256 + (r & 255)) * QKV_LD + 256 + (c & 255); }
                        else dst = O + A_OG / 2 + (size_t)r * 2048 + (c - 4096);
                        *(u32x4*)dst = w; } }
        } else if constexpr (MODE == 3) {
#pragma unroll
            for (int ai = 0; ai < 2; ++ai) {
                u32x4 zwv[4][2];
#pragma unroll
                for (int m = 0; m < 4; ++m)
#pragma unroll
                    for (int bj = 0; bj < 2; ++bj) zwv[m][bj] = *(const u32x4*)(Zp + (size_t)(row0 + ai * HALF + m * 16) * ldz + col0 + bj * HALF);
#pragma unroll
                for (int m = 0; m < 4; ++m) { const int r = row0 + ai * HALF + m * 16;
#pragma unroll
                    for (int bj = 0; bj < 2; ++bj) { const int c = col0 + bj * HALF;
                        const f32x4 b0 = *(const f32x4*)(bias + c), b1 = *(const f32x4*)(bias + c + 4);
                        const u32x4 zw = zwv[m][bj];
                        f32x4 v0 = acc[ai][bj][m][0] + b0, v1 = acc[ai][bj][m][1] + b1;
                        const float z[8] = {bflo(zw.x), bfhi(zw.x), bflo(zw.y), bfhi(zw.y), bflo(zw.z), bfhi(zw.z), bflo(zw.w), bfhi(zw.w)};
#pragma unroll
                        for (int e = 0; e < 4; ++e) { v0[e] = z[e] * sigmoidf_(v0[e]); v1[e] = z[4 + e] * sigmoidf_(v1[e]); }
                        u32x4 w; w.x = pk2(v0[0], v0[1]); w.y = pk2(v0[2], v0[3]); w.z = pk2(v1[0], v1[1]); w.w = pk2(v1[2], v1[3]);
                        *(u32x4*)(O + (size_t)r * ldc + c) = w; } } }
        } else {
            const int rt = u.pm * BM;
            const float* gp = gate + (size_t)cond_of_row(rt) * 6144;
            const float* bp = rt < NCTX ? base0 : base1 - (size_t)NCTX * D;
            const float* gnp = gain ? gain + (size_t)cond_of_row(rt) * D : gp;
            float ssq[2][4];
#pragma unroll
            for (int ai = 0; ai < 2; ++ai)
#pragma unroll
                for (int m = 0; m < 4; ++m) ssq[ai][m] = 0.f;
#pragma unroll
            for (int bj = 0; bj < 2; ++bj) { const int c = col0 + bj * HALF;
                const f32x4 g0 = *(const f32x4*)(gp + c), g1 = *(const f32x4*)(gp + c + 4);
                const f32x4 gn0 = *(const f32x4*)(gnp + c), gn1 = *(const f32x4*)(gnp + c + 4);
#pragma unroll
                for (int ai = 0; ai < 2; ++ai) {
                    f32x4 x0[4], x1[4];
#pragma unroll
                    for (int m = 0; m < 4; ++m) { const size_t off = (size_t)(row0 + ai * HALF + m * 16) * D + c; x0[m] = *(const f32x4*)(bp + off); x1[m] = *(const f32x4*)(bp + off + 4); }
#pragma unroll
                    for (int m = 0; m < 4; ++m) { const size_t off = (size_t)(row0 + ai * HALF + m * 16) * D + c;
                        const f32x4 y0 = x0[m] + g0 * acc[ai][bj][m][0], y1 = x1[m] + g1 * acc[ai][bj][m][1];
                        *(f32x4*)(out + off) = y0; *(f32x4*)(out + off + 4) = y1;
                        ssq[ai][m] += (y0[0] * y0[0] + y0[1] * y0[1]) + (y0[2] * y0[2] + y0[3] * y0[3]) + (y1[0] * y1[0] + y1[1] * y1[1]) + (y1[2] * y1[2] + y1[3] * y1[3]);
                        if (gain) { const f32x4 z0 = y0 * gn0, z1 = y1 * gn1; u32x4 w; w.x = pk2(z0[0], z0[1]); w.y = pk2(z0[2], z0[3]); w.z = pk2(z1[0], z1[1]); w.w = pk2(z1[2], z1[3]); *(u32x4*)(xn + off) = w; } } } }
            const int lane_ = fr + 16 * fq;
#pragma unroll
            for (int ai = 0; ai < 2; ++ai)
#pragma unroll
                for (int m = 0; m < 4; ++m) { float v = ssq[ai][m]; v += shfl_xor_l(v, 16, lane_); v += shfl_xor_l(v, 32, lane_);
                    if (fq == 0) atomicAdd(rowss_out + row0 + ai * HALF + m * 16, v); }
        }
    }
};

template <bool RPERM>
DI void p0_transpose_item(const float* W, int K, int N, bf16_t* WT, LAS float* scr, int item, int lane) {
    const int nblk = N / 32, kb = item / nblk, nb = item % nblk, k0 = 64 * kb, n0 = 32 * nb;
#pragma unroll 8
    for (int i = 0; i < 32; ++i) { const int kk = 2 * i + (lane >> 5); scr[kk * 33 + (lane & 31)] = W[(size_t)(k0 + kk) * N + n0 + (lane & 31)]; }
    LDS_WAIT();
    const int c = lane & 7;
#pragma unroll
    for (int j = 0; j < 4; ++j) { const int n = (lane >> 3) + 8 * j; const LAS float* s = scr + (8 * c) * 33 + n;
        u32x4 o; o.x = pk2(s[0 * 33], s[1 * 33]); o.y = pk2(s[2 * 33], s[3 * 33]); o.z = pk2(s[4 * 33], s[5 * 33]); o.w = pk2(s[6 * 33], s[7 * 33]);
        int nd = n0 + n;
        if (RPERM && nd < 2048) { const int f = nd & 31, s2 = (nd >> 5) & 1; nd = (nd & ~63) + 2 * f + s2; }
        *(u32x4*)(WT + (size_t)nd * K + k0 + 8 * c) = o; }
    LDS_WAIT();
}

DI void p0_prologue(const Args& a, LAS unsigned char* lds, int gw, int NGW, int wave, int lane) {
    LAS float* scr = (LAS float*)(lds + wave * 16384);
    unsigned char* ws = a.ws;
    constexpr int IT_HYIN = (D / 64) * (HY_IN / 32), IT_HYOUT = (D / 64) * (D / 32), IT_GLU = (512 / 64) * (512 / 32), IT_RETIN = (D / 64) * (RET_IN / 32),
                  IT_RETOUT = (2048 / 64) * (D / 32), IT_W1 = (D / 64) * (FF / 32), IT_W2 = (FF / 64) * (D / 32);
    constexpr int NIT = 2 * (IT_HYIN + IT_HYOUT + IT_GLU + IT_RETIN + IT_RETOUT) + 4 * (IT_W1 + IT_W2);
    for (int it = gw; it < NIT; it += NGW) {
        int r = it;
        if (r < 2 * IT_HYIN) { const int j = r / IT_HYIN; p0_transpose_item<false>(a.in[I_HYIN] + (size_t)j * D * HY_IN, D, HY_IN, (bf16_t*)(ws + WS_HYIN) + (size_t)j * D * HY_IN, scr, r % IT_HYIN, lane); continue; } r -= 2 * IT_HYIN;
        if (r < 2 * IT_HYOUT) { const int j = r / IT_HYOUT; p0_transpose_item<false>(a.in[I_HYOUT] + (size_t)j * D * D, D, D, (bf16_t*)(ws + WS_HYOUT) + (size_t)j * D * D, scr, r % IT_HYOUT, lane); continue; } r -= 2 * IT_HYOUT;
        if (r < 2 * IT_GLU) { const int j = r / IT_GLU; p0_transpose_item<false>(a.in[I_GLUW] + (size_t)j * 512 * 512, 512, 512, (bf16_t*)(ws + WS_GLU) + (size_t)j * 512 * 512, scr, r % IT_GLU, lane); continue; } r -= 2 * IT_GLU;
        if (r < 2 * IT_RETIN) { const int j = r / IT_RETIN; p0_transpose_item<true>(a.in[I_RETIN] + (size_t)j * D * RET_IN, D, RET_IN, (bf16_t*)(ws + WS_RETIN) + (size_t)j * D * RET_IN, scr, r % IT_RETIN, lane); continue; } r -= 2 * IT_RETIN;
        if (r < 2 * IT_RETOUT) { const int j = r / IT_RETOUT; p0_transpose_item<false>(a.in[I_RETOUT] + (size_t)j * 2048 * D, 2048, D, (bf16_t*)(ws + WS_RETOUT) + (size_t)j * 2048 * D, scr, r % IT_RETOUT, lane); continue; } r -= 2 * IT_RETOUT;
        if (r < 4 * IT_W1) { const int j = r / IT_W1; p0_transpose_item<false>(a.in[I_W1] + (size_t)j * D * FF, D, FF, (bf16_t*)(ws + WS_W1) + (size_t)j * D * FF, scr, r % IT_W1, lane); continue; } r -= 4 * IT_W1;
        { const int j = r / IT_W2; p0_transpose_item<false>(a.in[I_W2] + (size_t)j * FF * D, FF, D, (bf16_t*)(ws + WS_W2) + (size_t)j * FF * D, scr, r % IT_W2, lane); }
    }
    float* MODP = (float*)(ws + WS_MODP);
    for (int it = gw; it < 16 * 4 * 24; it += NGW) {
        const int nb = it % 24, l = (it / 24) & 3, kc = it / 96, k0 = kc * 64, col0 = nb * 256 + 4 * lane;
        float scv[5];
        { const float v = a.in[I_CCTX][k0 + lane]; scv[0] = siluf_(v); }
#pragma unroll
        for (int cnd = 1; cnd < 5; ++cnd) { const float v = a.in[I_C][(cnd - 1) * D + k0 + lane]; scv[cnd] = siluf_(v); }
        f32x4 acc[5];
#pragma unroll
        for (int cnd = 0; cnd < 5; ++cnd) acc[cnd] = (f32x4){0.f, 0.f, 0.f, 0.f};
        const float* wp = a.in[I_ADAW] + ((size_t)l * D + k0) * 6144 + col0;
#pragma unroll 8
        for (int kk = 0; kk < 64; ++kk) { const f32x4 w4 = *(const f32x4*)(wp + (size_t)kk * 6144);
#pragma unroll
            for (int cnd = 0; cnd < 5; ++cnd) { const float s = __shfl(scv[cnd], kk); acc[cnd] += w4 * s; } }
#pragma unroll
        for (int cnd = 0; cnd < 5; ++cnd) *(f32x4*)(MODP + ((size_t)((kc * 4 + l) * 5 + cnd)) * 6144 + col0) = acc[cnd];
    }
}

DI void norm_row_bf16(const f32x4 (&v)[4], bf16_t* orow, const float* w, const float* sc, const float* sh, int lane) {
    float s = 0.f;
#pragma unroll
    for (int j = 0; j < 4; ++j) { s += (v[j].x * v[j].x + v[j].y * v[j].y) + (v[j].z * v[j].z + v[j].w * v[j].w); }
    const float rstd = 1.f / sqrtf(wave_sum(s, lane) * (1.f / D) + EPS);
    unsigned long long* o8 = (unsigned long long*)orow + lane;
#pragma unroll
    for (int j = 0; j < 4; ++j) { const int c = 4 * lane + 256 * j; const f32x4 ww = *(const f32x4*)(w + c), cc = *(const f32x4*)(sc + c), hh = *(const f32x4*)(sh + c);
        const f32x4 o = v[j] * rstd * ww * (cc + 1.f) + hh;
        o8[64 * j] = (unsigned long long)pk2(o.x, o.y) | ((unsigned long long)pk2(o.z, o.w) << 32); }
}

struct S5C { float are, aim; bf16x8 bfrag[4]; bf16x8 cfrag[4]; };
DI void s5_consts(const Ctx& a, int j, int dir, int g, int lane, S5C& k, bool need_c) {
    const int l32 = lane & 31, h = lane >> 5;
    const int gi = (j * 2 + dir) * 32 + g; const size_t pidx = (size_t)gi * 64;
    const float dt = expf(a.in(I_LOGSTEP)[gi]);
    const float* lamre_ = a.in(I_LAMRE); const float* lamim_ = a.in(I_LAMIM); const float* bre_ = a.in(I_BRE); const float* bim_ = a.in(I_BIM);
#pragma unroll
    for (int pp = 0; pp < 2; ++pp) { const int p = pp * 32 + l32;
        const float lr = lamre_[pidx + p], li = lamim_[pidx + p]; const float mag = expf(lr * dt); const float abr = mag * cosf(li * dt), abi = mag * sinf(li * dt);
        if (pp == h) { k.are = abr; k.aim = abi; }
        const float den = lr * lr + li * li; const float fre = ((abr - 1.f) * lr + abi * li) / den, fim = (abi * lr - (abr - 1.f) * li) / den;
        const f32x4* br = (const f32x4*)(bre_ + (pidx + p) * 16 + 8 * h); const f32x4* bi = (const f32x4*)(bim_ + (pidx + p) * 16 + 8 * h);
        const f32x4 r0 = br[0], r1 = br[1], i0 = bi[0], i1 = bi[1];
        const float bre[8] = {r0.x, r0.y, r0.z, r0.w, r1.x, r1.y, r1.z, r1.w}, bim[8] = {i0.x, i0.y, i0.z, i0.w, i1.x, i1.y, i1.z, i1.w};
#pragma unroll
        for (int i = 0; i < 8; ++i) { k.bfrag[pp][i] = (short)f2bf(fre * bre[i] - fim * bim[i]); k.bfrag[2 + pp][i] = (short)f2bf(fre * bim[i] + fim * bre[i]); } }
    if (need_c) { const int c = lane & 15, kq = lane >> 4;
        const float* cre_ = a.in(I_CRE); const float* cim_ = a.in(I_CIM);
#pragma unroll
        for (int ks = 0; ks < 4; ++ks) { const int p0 = ks * 16 + kq * 4;
            const f32x4 cr = *(const f32x4*)(cre_ + ((size_t)gi * 16 + c) * 64 + p0), ci = *(const f32x4*)(cim_ + ((size_t)gi * 16 + c) * 64 + p0);
            k.cfrag[ks][0] = (short)f2bf(cr.x); k.cfrag[ks][1] = (short)f2bf(-ci.x); k.cfrag[ks][2] = (short)f2bf(cr.y); k.cfrag[ks][3] = (short)f2bf(-ci.y);
            k.cfrag[ks][4] = (short)f2bf(cr.z); k.cfrag[ks][5] = (short)f2bf(-ci.z); k.cfrag[ks][6] = (short)f2bf(cr.w); k.cfrag[ks][7] = (short)f2bf(-ci.w); } }
}
template <bool FULL>
DI void s5_scan256(const S5C& k, int dir, int g, int r0, float& xr, float& xi, LAS unsigned char* wl, const bf16_t* PROJ, float* Y, int lane) {
    const int l32 = lane & 31, h = lane >> 5;
    LAS float* wf = (LAS float*)wl;
    f32x16 zero; for (int i = 0; i < 16; ++i) zero[i] = 0.f;
    auto tok = [&](int s) { return dir ? 255 - s : s; };
    bf16x8 uf = *(const bf16x8*)(PROJ + (size_t)(r0 + tok(l32)) * HY_IN + g * 16 + 8 * h);
    for (int q = 0; q < 8; ++q) {
        bf16x8 ufn = uf;
        if (q < 7) ufn = *(const bf16x8*)(PROJ + (size_t)(r0 + tok(32 * (q + 1) + l32)) * HY_IN + g * 16 + 8 * h);
#pragma unroll
        for (int pp = 0; pp < 2; ++pp) { const f32x16 are_ = MFMA32(uf, k.bfrag[pp], zero), aim_ = MFMA32(uf, k.bfrag[2 + pp], zero);
#pragma unroll
            for (int i = 0; i < 16; ++i) { typedef float f32x2 __attribute__((ext_vector_type(2))); *(LAS f32x2*)(wf + crow(i, h) * 132 + 2 * (pp * 32 + l32)) = (f32x2){are_[i], aim_[i]}; } }
        WAVE_SYNC();
#pragma unroll 1
        for (int m0 = 0; m0 < 32; m0 += 8) {
            typedef float f32x2 __attribute__((ext_vector_type(2)));
            f32x2 b[8];
#pragma unroll
            for (int i = 0; i < 8; ++i) b[i] = *(const LAS f32x2*)(wf + (m0 + i) * 132 + 2 * lane);
            asm volatile("s_waitcnt lgkmcnt(0)" ::: "memory");
            {
                f32x2 xv = {xr, xi}; const f32x2 a1 = {k.are, k.are}, a2 = {-k.aim, k.aim};
#pragma unroll
                for (int i = 0; i < 8; ++i) {
                    xv = a1 * xv + (a2 * __builtin_shufflevector(xv, xv, 1, 0) + b[i]);
                    if (FULL) *(LAS unsigned*)(wl + (m0 + i) * 528 + 4 * lane) = cvt_pk_bf16(xv.x, xv.y);
                }
                xr = xv.x; xi = xv.y; }
        }
        if (FULL) {
            WAVE_SYNC();
            const int c = lane & 15, kq = lane >> 4;
#pragma unroll
            for (int tt = 0; tt < 2; ++tt) { f32x4 y = (f32x4){0.f, 0.f, 0.f, 0.f};
#pragma unroll
                for (int ks = 0; ks < 4; ++ks) { const bf16x8 af = *(const LAS bf16x8*)(wl + (tt * 16 + c) * 528 + (ks * 32 + kq * 8) * 2); y = MFMA16(af, k.cfrag[ks], y); }
#pragma unroll
                for (int r = 0; r < 4; ++r) { const int row = r0 + tok(32 * q + tt * 16 + 4 * kq + r); Y[(size_t)row * 512 + g * 16 + c] = y[r]; } }
            WAVE_SYNC();
        }
        uf = ufn;
    }
}
DI void s5_full_dir(const Ctx& a, int j, int sc, int g, int dir, LAS unsigned char* wl, int lane) {
    unsigned char* ws = a.ws(); const bf16_t* PROJ = (const bf16_t*)(ws + WS_A); float* Y = (float*)(ws + WS_A + (dir ? A_YB : A_YF));
    const float* LOC = (const float*)(ws + WS_LOC);
    const int r0 = sc * 256; const bool latent = sc >= 32; const int lb = (sc - 32) >> 3, lc = (sc - 32) & 7;
    S5C k; s5_consts(a, j, dir, g, lane, k, true);
    float xr = 0.f, xi = 0.f;
    if (latent) {
        float pr = k.are, pi = k.aim;
#pragma unroll
        for (int s = 0; s < 8; ++s) { const float t = pr * pr - pi * pi; pi = 2.f * pr * pi; pr = t; asm volatile("" : "+v"(pr), "+v"(pi)); }
        const size_t hidx = ((((size_t)lb * 2 + j) * 2 + dir) * 32 + g) * 64 + lane;
        xr = a.in(I_S5RE)[hidx]; xi = a.in(I_S5IM)[hidx];
        typedef float f32x2 __attribute__((ext_vector_type(2)));
        f32x2 lv[7];
#pragma unroll
        for (int q = 0; q < 7; ++q) { const int c2 = dir ? 7 - q : q; lv[q] = *(const f32x2*)(LOC + ((((size_t)(lb * 8 + c2) * 32 + g) * 2 + dir) * 64 + lane) * 2); }
        const int npre = dir ? 7 - lc : lc;
#pragma unroll
        for (int q = 0; q < 7; ++q) if (q < npre) { const float t = pr * xr - pi * xi + lv[q].x; xi = pr * xi + pi * xr + lv[q].y; xr = t; }
    }
    s5_scan256<true>(k, dir, g, r0, xr, xi, wl, PROJ, Y, lane);
    if (!latent) { const size_t oidx = ((((size_t)sc * 2 + j) * 2 + dir) * 32 + g) * 64 + lane; a.out()[O_S5RE + oidx] = xr; a.out()[O_S5IM + oidx] = xi; }
}
DI void s5_combine(const Ctx& a, int j, int sc, int g, int half, int lane) {
    unsigned char* ws = a.ws(); const bf16_t* PROJ = (const bf16_t*)(ws + WS_A); const float* YF = (const float*)(ws + WS_A + A_YF); const float* YB = (const float*)(ws + WS_A + A_YB); bf16_t* Z = (bf16_t*)(ws + WS_A + A_Z);
    const int ch = g * 16 + (lane & 3) * 4; const f32x4 dv = *(const f32x4*)(a.in(I_S5D) + j * 512 + ch);
    f32x4 yfv[8], ybv[8]; u32x2 uwv[8];
#pragma unroll
    for (int it = 0; it < 8; ++it) { const int row = sc * 256 + half * 128 + it * 16 + (lane >> 2);
        yfv[it] = *(const f32x4*)(YF + (size_t)row * 512 + ch); ybv[it] = *(const f32x4*)(YB + (size_t)row * 512 + ch); uwv[it] = *(const u32x2*)(PROJ + (size_t)row * HY_IN + ch); }
#pragma unroll
    for (int it = 0; it < 8; ++it) { const int row = sc * 256 + half * 128 + it * 16 + (lane >> 2);
        const f32x4 yf = yfv[it], yb = ybv[it]; const u32x2 uw = uwv[it];
        const float z0 = gelu_tanh(yf.x + yb.x + dv.x * bflo(uw.x)), z1 = gelu_tanh(yf.y + yb.y + dv.y * bfhi(uw.x)), z2 = gelu_tanh(yf.z + yb.z + dv.z * bflo(uw.y)), z3 = gelu_tanh(yf.w + yb.w + dv.w * bfhi(uw.y));
        u32x2 w; w.x = cvt_pk_bf16(z0, z1); w.y = cvt_pk_bf16(z2, z3); *(u32x2*)(Z + (size_t)row * 512 + ch) = w; }
}
DI void s5_local_unit(const Ctx& a, int j, int lcg, int g, int dir, LAS unsigned char* wl, int lane) {
    unsigned char* ws = a.ws(); const bf16_t* PROJ = (const bf16_t*)(ws + WS_A); float* LOC = (float*)(ws + WS_LOC);
    S5C k; s5_consts(a, j, dir, g, lane, k, false);
    float xr = 0.f, xi = 0.f;
    s5_scan256<false>(k, dir, g, (32 + lcg) * 256, xr, xi, wl, PROJ, nullptr, lane);
    float* lp = LOC + ((((size_t)lcg * 32 + g) * 2 + dir) * 64 + lane) * 2; lp[0] = xr; lp[1] = xi;
}
DI void s5_phase_full(const Ctx& a, int j, int first, LAS unsigned char* wl, int gw, int NGW, int lane) {
    const int ntrip = (2048 + NGW - 1) / NGW;
    for (int tr = 0; tr < ntrip; ++tr) { const int wu = gw + tr * NGW; const bool on = wu < 2048; const int u = wu >> 1, dir = wu & 1;
        if (on) s5_full_dir(a, j, first + (u >> 5), u & 31, dir, wl, lane);
        asm volatile("s_waitcnt vmcnt(0)" ::: "memory"); __syncthreads();
        if (on) s5_combine(a, j, first + (u >> 5), u & 31, dir, lane);
    }
}
DI void conv_part(const Ctx& a, int j, int gtid, int gthreads) {
    unsigned char* ws = a.ws(); const bf16_t* PROJ = (const bf16_t*)(ws + WS_A); bf16_t* MIX = (bf16_t*)(ws + WS_A + A_MIX);
    const float* cw = a.in(I_CONVW) + j * 3 * 512; const float* cb = a.in(I_CONVB) + j * 512;
    const float* cwp = cw; (void)cwp;
    for (int it = gtid; it < NTOK * 64; it += gthreads) {
        const int r = it >> 6, w0 = (it & 63) * 8;
        const int t = r < NCTX ? (r & 255) : ((r - NCTX) & 2047); const int L = r < NCTX ? 256 : 2048;
        float cvm[8], cv0[8], cvp[8];
        auto ldcv = [&](int rr, float (&o)[8], bool valid) {
            if (!valid) { for (int e = 0; e < 8; ++e) o[e] = 0.f; return; }
            const u32x4 cg4 = *(const u32x4*)(PROJ + (size_t)rr * HY_IN + 1024 + w0), v4 = *(const u32x4*)(PROJ + (size_t)rr * HY_IN + 1536 + w0);
            o[0] = bflo(cg4.x) * bflo(v4.x); o[1] = bfhi(cg4.x) * bfhi(v4.x); o[2] = bflo(cg4.y) * bflo(v4.y); o[3] = bfhi(cg4.y) * bfhi(v4.y);
            o[4] = bflo(cg4.z) * bflo(v4.z); o[5] = bfhi(cg4.z) * bfhi(v4.z); o[6] = bflo(cg4.w) * bflo(v4.w); o[7] = bfhi(cg4.w) * bfhi(v4.w); };
        ldcv(r - 1, cvm, t > 0); ldcv(r, cv0, true); ldcv(r + 1, cvp, t < L - 1);
        const u32x4 bg4 = *(const u32x4*)(PROJ + (size_t)r * HY_IN + 512 + w0);
        const float bg[8] = {bflo(bg4.x), bfhi(bg4.x), bflo(bg4.y), bfhi(bg4.y), bflo(bg4.z), bfhi(bg4.z), bflo(bg4.w), bfhi(bg4.w)};
        float o[8];
#pragma unroll
        for (int e = 0; e < 8; ++e) o[e] = bg[e] * (cw[w0 + e] * cvm[e] + cw[512 + w0 + e] * cv0[e] + cw[1024 + w0 + e] * cvp[e] + cb[w0 + e]);
        u32x4 w; w.x = pk2(o[0], o[1]); w.y = pk2(o[2], o[3]); w.z = pk2(o[4], o[5]); w.w = pk2(o[6], o[7]);
        *(u32x4*)(MIX + (size_t)r * D + 512 + w0) = w;
    }
}

constexpr int VT_PITCH = 144, KS_PITCH = 272;
DI int unperm_dk(int dkp) { return (dkp & 64) + ((dkp & 63) >> 1) + 32 * (dkp & 1); }
DI void vt_load(u32x4 (&r)[4], const bf16_t* src, int wave, int lane) {
    const int kp = lane & 31;
#pragma unroll
    for (int it = 0; it < 2; ++it) { const int dg8 = it * 16 + wave * 2 + (lane >> 5);
        r[2 * it] = *(const u32x4*)(src + (size_t)(2 * kp) * QKV_LD + dg8 * 8); r[2 * it + 1] = *(const u32x4*)(src + (size_t)(2 * kp + 1) * QKV_LD + dg8 * 8); }
}
DI void vt_store(LAS unsigned char* VT, const u32x4 (&r)[4], int wave, int lane) {
    const int kp = lane & 31;
#pragma unroll
    for (int it = 0; it < 2; ++it) { const int dg8 = it * 16 + wave * 2 + (lane >> 5);
        LAS unsigned char* dst = VT + (dg8 * 8) * VT_PITCH + kp * 4;
        const unsigned x0[4] = {r[2 * it].x, r[2 * it].y, r[2 * it].z, r[2 * it].w}, x1[4] = {r[2 * it + 1].x, r[2 * it + 1].y, r[2 * it + 1].z, r[2 * it + 1].w};
#pragma unroll
        for (int e = 0; e < 4; ++e) { *(LAS unsigned*)(dst + (2 * e) * VT_PITCH) = (x0[e] & 0xffffu) | (x1[e] << 16); *(LAS unsigned*)(dst + (2 * e + 1) * VT_PITCH) = (x0[e] >> 16) | (x1[e] & 0xffff0000u); } }
}
DI float log2_sigmoid(float x) { return -log2f(1.f + exp2f(-x * 1.4426950408889634f)); }
DI void ret_state_unit(const Ctx& a, int j, int sc, int hd, LAS unsigned char* lds, int wave, int lane) {
    asm volatile("" : "+v"(lane));
    unsigned char* ws = a.ws(); const bf16_t* PROJ = (const bf16_t*)(ws + WS_A);
    const int l32 = lane & 31, h = lane >> 5, r0 = sc * 256;
    const float lgf = log2_sigmoid(a.in(I_GAMMA)[(j * 2 + 0) * 8 + hd]), lgb = log2_sigmoid(a.in(I_GAMMA)[(j * 2 + 1) * 8 + hd]);
    LAS unsigned char* VT = lds; LAS unsigned char* KTf = lds + 36864; LAS unsigned char* KTb = lds + 36864 + 18432;
    f32x16 acc[2][4];
#pragma unroll
    for (int d = 0; d < 2; ++d)
#pragma unroll
        for (int n = 0; n < 4; ++n) for (int i = 0; i < 16; ++i) acc[d][n][i] = 0.f;
    const int kp = lane & 31, dg8k = wave * 2 + (lane >> 5);
    const bf16_t* blk = PROJ + (size_t)(sc * 8 + hd) * 256 * QKV_LD;
    const bf16_t* vsrc = blk + 256; const bf16_t* ksrc = blk + 128 + dg8k * 8;
    u32x4 vr[4], k0r, k1r;
    vt_load(vr, vsrc, wave, lane); k0r = *(const u32x4*)(ksrc + (size_t)(2 * kp) * QKV_LD); k1r = *(const u32x4*)(ksrc + (size_t)(2 * kp + 1) * QKV_LD);
    for (int jb = 0; jb < 4; ++jb) {
        __syncthreads();
        vt_store(VT, vr, wave, lane);
        { const int key = jb * 64 + 2 * kp;
            const float sf0 = __builtin_amdgcn_exp2f(lgf * (float)(255 - key)), sf1 = __builtin_amdgcn_exp2f(lgf * (float)(254 - key)), sb0 = __builtin_amdgcn_exp2f(lgb * (float)key), sb1 = __builtin_amdgcn_exp2f(lgb * (float)(key + 1));
            const unsigned x0[4] = {k0r.x, k0r.y, k0r.z, k0r.w}, x1[4] = {k1r.x, k1r.y, k1r.z, k1r.w};
#pragma unroll
            for (int e = 0; e < 4; ++e) {
                const float k0l = bflo(x0[e]), k0h = bfhi(x0[e]), k1l = bflo(x1[e]), k1h = bfhi(x1[e]);
                const int off = (dg8k * 8 + 2 * e) * VT_PITCH + kp * 4;
                *(LAS unsigned*)(KTf + off) = cvt_pk_bf16(k0l * sf0, k1l * sf1); *(LAS unsigned*)(KTf + off + VT_PITCH) = cvt_pk_bf16(k0h * sf0, k1h * sf1);
                *(LAS unsigned*)(KTb + off) = cvt_pk_bf16(k0l * sb0, k1l * sb1); *(LAS unsigned*)(KTb + off + VT_PITCH) = cvt_pk_bf16(k0h * sb0, k1h * sb1); } }
        __syncthreads();
        if (jb < 3) { vt_load(vr, vsrc + (size_t)(jb + 1) * 64 * QKV_LD, wave, lane);
            k0r = *(const u32x4*)(ksrc + (size_t)((jb + 1) * 64 + 2 * kp) * QKV_LD); k1r = *(const u32x4*)(ksrc + (size_t)((jb + 1) * 64 + 2 * kp + 1) * QKV_LD); }
        bf16x8 fa[2], fb[2][4], fc[2][4];
#define LDST(buf, ks_) do { fa[buf] = *(const LAS bf16x8*)(VT + (32 * wave + l32) * VT_PITCH + ((ks_) * 16 + 8 * h) * 2); _Pragma("unroll") for (int n = 0; n < 4; ++n) { \
            fb[buf][n] = *(const LAS bf16x8*)(KTf + (n * 32 + l32) * VT_PITCH + ((ks_) * 16 + 8 * h) * 2); fc[buf][n] = *(const LAS bf16x8*)(KTb + (n * 32 + l32) * VT_PITCH + ((ks_) * 16 + 8 * h) * 2); } } while (0)
        LDST(0, 0);
#pragma unroll
        for (int ks = 0; ks < 4; ++ks) {
            if (ks < 3) { if (ks & 1) LDST(0, ks + 1); else LDST(1, ks + 1); }
            __builtin_amdgcn_sched_barrier(0);
#pragma unroll
            for (int n = 0; n < 4; ++n) { acc[0][n] = MFMA32(fa[ks & 1], fb[ks & 1][n], acc[0][n]); acc[1][n] = MFMA32(fa[ks & 1], fc[ks & 1][n], acc[1][n]); }
            __builtin_amdgcn_sched_barrier(0); }
#undef LDST
    }
    if (sc < 32) {
#pragma unroll
        for (int d = 0; d < 2; ++d) { float* op = a.out() + O_RET + ((((size_t)sc * 2 + j) * 2 + d) * 8 + hd) * (size_t)(128 * 256);
#pragma unroll
            for (int n = 0; n < 4; ++n) { const int dk = unperm_dk(n * 32 + l32);
#pragma unroll
                for (int g4 = 0; g4 < 4; ++g4) *(f32x4*)(op + (size_t)dk * 256 + 32 * wave + 8 * g4 + 4 * h) = (f32x4){acc[d][n][4 * g4], acc[d][n][4 * g4 + 1], acc[d][n][4 * g4 + 2], acc[d][n][4 * g4 + 3]}; } }
    } else {
        const int lb = (sc - 32) >> 3, lc = (sc - 32) & 7; bf16_t* LOCAL = (bf16_t*)(ws + WS_LOCAL);
#pragma unroll
        for (int d = 0; d < 2; ++d) { bf16_t* op = LOCAL + ((((size_t)lb * 8 + hd) * 8 + lc) * 2 + d) * (size_t)(256 * 128);
#pragma unroll
            for (int n = 0; n < 4; ++n)
#pragma unroll
                for (int r = 0; r < 16; ++r) op[(size_t)(32 * wave + crow(r, h)) * 128 + n * 32 + l32] = (bf16_t)f2bf(acc[d][n][r]); }
    }
}
DI void ret_prefix(const Ctx& a, int j, int gtid, int gthreads) {
    unsigned char* ws = a.ws(); const bf16_t* LOCAL = (const bf16_t*)(ws + WS_LOCAL); bf16_t* SIN = (bf16_t*)(ws + WS_XN);
    for (int it = gtid; it < 4 * 8 * 2 * 4096; it += gthreads) {
        const int e8 = it & 4095, d = (it >> 12) & 1, hd = (it >> 13) & 7, lb = it >> 16;
        const int dv = e8 >> 4, dk0 = (e8 & 15) * 8;
        const float lg = log2_sigmoid(a.in(I_GAMMA)[(j * 2 + d) * 8 + hd]);
        const float cd = exp2f(lg * 256.f);
        const float* s0 = a.in(I_SRET) + ((((size_t)lb * 2 + j) * 2 + d) * 8 + hd) * (size_t)(128 * 256);
        float s[8];
#pragma unroll
        for (int e = 0; e < 8; ++e) s[e] = s0[(size_t)unperm_dk(dk0 + e) * 256 + dv];
        u32x4 lv[8];
#pragma unroll
        for (int cc = 0; cc < 8; ++cc) { const int c = d ? 7 - cc : cc; lv[cc] = *(const u32x4*)(LOCAL + ((((size_t)lb * 8 + hd) * 8 + c) * 2 + d) * (size_t)(256 * 128) + (size_t)dv * 128 + dk0); }
#pragma unroll
        for (int cc = 0; cc < 8; ++cc) { const int c = d ? 7 - cc : cc;
            const size_t blk = ((((size_t)lb * 8 + hd) * 8 + c) * 2 + d) * (size_t)(256 * 128) + (size_t)dv * 128 + dk0;
            u32x4 w; w.x = pk2(s[0], s[1]); w.y = pk2(s[2], s[3]); w.z = pk2(s[4], s[5]); w.w = pk2(s[6], s[7]);
            *(u32x4*)(SIN + blk) = w;
            const u32x4 l4 = lv[cc];
            s[0] = cd * s[0] + bflo(l4.x); s[1] = cd * s[1] + bfhi(l4.x); s[2] = cd * s[2] + bflo(l4.y); s[3] = cd * s[3] + bfhi(l4.y);
            s[4] = cd * s[4] + bflo(l4.z); s[5] = cd * s[5] + bfhi(l4.z); s[6] = cd * s[6] + bflo(l4.w); s[7] = cd * s[7] + bfhi(l4.w); }
    }
}
DI void ret_out_unit(const Ctx& a, int j, int sc, int hd, LAS unsigned char* lds, int wave, int lane, bf16_t* dup_dst = nullptr) {
    asm volatile("v_mbcnt_lo_u32_b32 %0, -1, 0\n\tv_mbcnt_hi_u32_b32 %0, -1, %0" : "=v"(lane));
    unsigned char* ws = a.ws(); bf16_t* PROJ = (bf16_t*)(ws + WS_A);
    const int l32 = lane & 31, h = lane >> 5, r0 = sc * 256, tid = wave * 64 + lane;
    const float lgf = log2_sigmoid(a.in(I_GAMMA)[(j * 2 + 0) * 8 + hd]), lgb = log2_sigmoid(a.in(I_GAMMA)[(j * 2 + 1) * 8 + hd]);
    LAS unsigned char* VT = lds; LAS unsigned char* KS = lds + 36864;
    const int qi = 32 * wave + l32;
    LAS unsigned char* QS = lds + 36864 + 17408;
    const bf16_t* blk = PROJ + (size_t)(sc * 8 + hd) * 256 * QKV_LD;
    __syncthreads();
#pragma unroll
    for (int it = 0; it < 8; ++it) { const int id = tid + it * 512, row = id >> 4, part = id & 15;
        *(LAS u32x4*)(QS + row * KS_PITCH + part * 16) = *(const u32x4*)(blk + (size_t)row * QKV_LD + part * 8); }
    __syncthreads();
    const LAS unsigned char* qrow = QS + qi * KS_PITCH + 16 * h;
#define QF(ks) (*(const LAS bf16x8*)(qrow + (ks) * 32))
    f32x16 acc[8];
#pragma unroll
    for (int t = 0; t < 8; ++t) for (int i = 0; i < 16; ++i) acc[t][i] = 0.f;
    if (sc >= 32) {
        const int lb = (sc - 32) >> 3, lc = (sc - 32) & 7; const bf16_t* SIN = (const bf16_t*)(ws + WS_XN);
        const bf16_t* sf = SIN + ((((size_t)lb * 8 + hd) * 8 + lc) * 2 + 0) * (size_t)(256 * 128); const bf16_t* sb = sf + 256 * 128;
        const float wf_ = __builtin_amdgcn_exp2f(lgf * (float)(qi + 1)), wb_ = __builtin_amdgcn_exp2f(lgb * (float)(256 - qi)); const float ratio = __builtin_amdgcn_exp2f(lgf * (float)(qi + 1) - lgb * (float)(256 - qi));
        bf16x8 qq[8];
#pragma unroll
        for (int ks = 0; ks < 8; ++ks) qq[ks] = QF(ks);
        LAS unsigned char* SS = lds;
        u32x4 sr[4][4];
#pragma unroll
        for (int rd = 0; rd < 4; ++rd) { const bf16_t* sp_ = ((rd & 1) ? sb : sf) + (size_t)(rd >> 1) * 128 * 128;
#pragma unroll
            for (int it = 0; it < 4; ++it) { const int id = tid + it * 512; sr[rd][it] = *(const u32x4*)(sp_ + (size_t)(id >> 4) * 128 + (id & 15) * 8); } }
#pragma unroll
        for (int rd = 0; rd < 4; ++rd) {
            __syncthreads();
#pragma unroll
            for (int it = 0; it < 4; ++it) { const int id = tid + it * 512; *(LAS u32x4*)(SS + (id >> 4) * KS_PITCH + (id & 15) * 16) = sr[rd][it]; }
            __syncthreads();
#pragma unroll
            for (int tt = 0; tt < 4; ++tt) { const int t = (rd >> 1) * 4 + tt;
                bf16x8 af[8];
#pragma unroll
                for (int ks = 0; ks < 8; ++ks) af[ks] = *(const LAS bf16x8*)(SS + (tt * 32 + l32) * KS_PITCH + (ks * 16 + 8 * h) * 2);
                __builtin_amdgcn_sched_barrier(0);
#pragma unroll
                for (int ks = 0; ks < 8; ++ks) acc[t] = MFMA32(af[ks], qq[ks], acc[t]);
                acc[t] = acc[t] * ((rd & 1) ? wb_ : ratio);
                __builtin_amdgcn_sched_barrier(0); }
        }
    }
    const bf16_t* vsrc = blk + 256; const bf16_t* ksrc = blk + (size_t)(tid >> 4) * QKV_LD + 128 + (tid & 15) * 8;
    u32x4 vr[4], kr0, kr1;
    vt_load(vr, vsrc, wave, lane); kr0 = *(const u32x4*)ksrc; kr1 = *(const u32x4*)(ksrc + (size_t)32 * QKV_LD);
    for (int jb = 0; jb < 4; ++jb) {
        __syncthreads();
        vt_store(VT, vr, wave, lane);
        *(LAS u32x4*)(KS + (tid >> 4) * KS_PITCH + (tid & 15) * 16) = kr0; *(LAS u32x4*)(KS + (32 + (tid >> 4)) * KS_PITCH + (tid & 15) * 16) = kr1;
        __syncthreads();
        if (jb < 3) { vt_load(vr, vsrc + (size_t)(jb + 1) * 64 * QKV_LD, wave, lane); kr0 = *(const u32x4*)(ksrc + (size_t)(jb + 1) * 64 * QKV_LD); kr1 = *(const u32x4*)(ksrc + (size_t)((jb + 1) * 64 + 32) * QKV_LD); }
#pragma unroll
        for (int mt = 0; mt < 2; ++mt) {
            f32x16 st; for (int i = 0; i < 16; ++i) st[i] = 0.f;
#pragma unroll
            for (int hf = 0; hf < 2; ++hf) { bf16x8 kf[4], qq[4];
#pragma unroll
                for (int i = 0; i < 4; ++i) { const int ks = hf * 4 + i; kf[i] = *(const LAS bf16x8*)(KS + (mt * 32 + l32) * KS_PITCH + (ks * 16 + 8 * h) * 2); qq[i] = QF(ks); }
                __builtin_amdgcn_sched_barrier(0);
#pragma unroll
                for (int i = 0; i < 4; ++i) st = MFMA32(kf[i], qq[i], st);
                __builtin_amdgcn_sched_barrier(0); }
            bf16x8 vf[8];
#define LDVF(s_, t0_) do { _Pragma("unroll") for (int t = (t0_); t < (t0_) + 4; ++t) { const LAS unsigned char* vp = VT + (t * 32 + l32) * VT_PITCH + (mt * 32 + 16 * (s_) + 4 * h) * 2; \
                const s16x4 lo = *(const LAS s16x4*)vp, hi = *(const LAS s16x4*)(vp + 16); vf[t] = __builtin_shufflevector(lo, hi, 0, 1, 2, 3, 4, 5, 6, 7); } } while (0)
            LDVF(0, 0); LDVF(0, 4);
            __builtin_amdgcn_sched_barrier(0);
#pragma unroll
            for (int r = 0; r < 16; ++r) { const int kj = jb * 64 + mt * 32 + crow(r, h); const int df = qi - kj;
                const float dcy = df == 0 ? 2.f : __builtin_amdgcn_exp2f((df > 0 ? lgf : -lgb) * (float)df); st[r] *= dcy; }
#pragma unroll
            for (int s = 0; s < 2; ++s) {
                u32x4 pw;
                asm volatile("v_cvt_pk_bf16_f32 %0, %4, %5\n\tv_cvt_pk_bf16_f32 %1, %6, %7\n\tv_cvt_pk_bf16_f32 %2, %8, %9\n\tv_cvt_pk_bf16_f32 %3, %10, %11\n\ts_nop 1"
                             : "=&v"(pw[0]), "=&v"(pw[1]), "=&v"(pw[2]), "=&v"(pw[3])
                             : "v"(st[8 * s]), "v"(st[8 * s + 1]), "v"(st[8 * s + 2]), "v"(st[8 * s + 3]), "v"(st[8 * s + 4]), "v"(st[8 * s + 5]), "v"(st[8 * s + 6]), "v"(st[8 * s + 7]));
                const bf16x8 pf = __builtin_bit_cast(bf16x8, pw);
                __builtin_amdgcn_sched_barrier(0);
#pragma unroll
                for (int t = 0; t < 4; ++t) acc[t] = MFMA32(vf[t], pf, acc[t]);
                __builtin_amdgcn_sched_barrier(0);
                if (s == 0) { LDVF(1, 0); __builtin_amdgcn_sched_barrier(0); }
#pragma unroll
                for (int t = 4; t < 8; ++t) acc[t] = MFMA32(vf[t], pf, acc[t]);
                __builtin_amdgcn_sched_barrier(0);
                if (s == 0) { LDVF(1, 4); __builtin_amdgcn_sched_barrier(0); }
            }
#undef LDVF
        }
    }
    float ss = 0.f;
#pragma unroll
    for (int t = 0; t < 8; ++t) for (int i = 0; i < 16; ++i) ss += acc[t][i] * acc[t][i];
    ss += shfl_xor_l(ss, 32, lane);
    const float rstd = 1.f / sqrtf(ss * (1.f / 256.f) + EPS);
    bf16_t* grow = PROJ + A_OG / 2 + (size_t)(r0 + qi) * 2048 + hd * 256; const float* gn = a.in(I_GNW) + j * 2048 + hd * 256;
#pragma unroll
    for (int tb = 0; tb < 8; tb += 2) {
        u32x2 gwv[8]; f32x4 gnv[8];
#pragma unroll
        for (int q = 0; q < 8; ++q) { const int dv0 = 32 * (tb + (q >> 2)) + 8 * (q & 3) + 4 * h; gwv[q] = *(const u32x2*)(grow + dv0); gnv[q] = *(const f32x4*)(gn + dv0); }
#pragma unroll
        for (int q = 0; q < 8; ++q) { const int t = tb + (q >> 2), g4 = q & 3, dv0 = 32 * t + 8 * g4 + 4 * h;
            const float o0 = siluf_(bflo(gwv[q].x)) * acc[t][4 * g4] * rstd * gnv[q].x, o1 = siluf_(bfhi(gwv[q].x)) * acc[t][4 * g4 + 1] * rstd * gnv[q].y,
                        o2 = siluf_(bflo(gwv[q].y)) * acc[t][4 * g4 + 2] * rstd * gnv[q].z, o3 = siluf_(bfhi(gwv[q].y)) * acc[t][4 * g4 + 3] * rstd * gnv[q].w;
            u32x2 w; w.x = cvt_pk_bf16(o0, o1); w.y = cvt_pk_bf16(o2, o3); *(u32x2*)(grow + dv0) = w; }
    }
#undef QF
}


#define XB_TMO      128
#define XB_XCNT(j)  (256  + 64 * (j))
#define XB_XSUB(j)  (1280 + 64 * (j))
#define XB_XGEN(j)  (2304 + 64 * (j))
#define XB_TOP      3328
#define XB_TOPGEN   3392
#define XCD_BAR_WORDS 3456
#define XB_SPIN_CAP (1u << 18)
DI unsigned xb_ld(unsigned* p)              { return __hip_atomic_load(p, __ATOMIC_RELAXED, __HIP_MEMORY_SCOPE_AGENT); }
DI unsigned xb_add(unsigned* p, unsigned v) { return __hip_atomic_fetch_add(p, v, __ATOMIC_RELAXED, __HIP_MEMORY_SCOPE_AGENT); }
DI unsigned xb_xcc_id() { return (unsigned)__builtin_amdgcn_s_getreg((3 << 11) | 20) & 0xFu; }
#define XB_SPIN(cond, bar) do { unsigned _sp = 0; while (cond) { __builtin_amdgcn_s_sleep(1); \
    if ((++_sp & 255u) == 0u) { if (xb_ld(&(bar)[XB_TMO])) break; if (_sp > XB_SPIN_CAP) { atomicAdd(&(bar)[XB_TMO], 1u); break; } } } } while (0)
struct XcdBarrier { unsigned* bar; unsigned x; volatile LAS unsigned* st; };
DI void xcd_barrier_complete(unsigned* bar, unsigned x, unsigned& nloc, unsigned& nx) {
    const unsigned G = gridDim.x * gridDim.y * gridDim.z;
    unsigned sum, cnt, mine, sp = 0u;
    for (;;) {
        sum = 0u; cnt = 0u; mine = 0u;
#pragma unroll
        for (unsigned j = 0; j < 16; ++j) { const unsigned c = xb_ld(&bar[XB_XCNT(j)]); sum += c; cnt += (c > 0u) ? 1u : 0u; mine = (j == x) ? c : mine; }
        if (sum == G) break;
        __builtin_amdgcn_s_sleep(1);
        if ((++sp & 255u) == 0u) { if (xb_ld(&bar[XB_TMO])) break; if (sp > XB_SPIN_CAP) { atomicAdd(&bar[XB_TMO], 1u); break; } }
    }
    nloc = mine > 0u ? mine : 1u; nx = cnt > 0u ? cnt : 1u;
}
DI void xcd_barrier(const XcdBarrier& b) {
    asm volatile("s_waitcnt vmcnt(0)" ::: "memory");
    __syncthreads();
    if (threadIdx.x == 0) {
        unsigned* bar = b.bar;
        __builtin_amdgcn_s_waitcnt(0);
        unsigned nloc = b.st[0], nx = b.st[1];
        if (nloc == 0u) { xcd_barrier_complete(bar, b.x, nloc, nx); b.st[0] = nloc; b.st[1] = nx; }
        const unsigned old = xb_add(&bar[XB_XSUB(b.x)], 1u);
        const unsigned gen = old / nloc;
        if (old + 1u == (gen + 1u) * nloc) {
            __builtin_amdgcn_fence(__ATOMIC_RELEASE, "agent");
            asm volatile("s_waitcnt vmcnt(0)" ::: "memory");
            const unsigned og = xb_add(&bar[XB_TOP], 1u);
            const unsigned tg = og / nx;
            if (og + 1u == (tg + 1u) * nx) xb_add(&bar[XB_TOPGEN], 1u);
            else XB_SPIN(xb_ld(&bar[XB_TOPGEN]) == tg, bar);
            __builtin_amdgcn_fence(__ATOMIC_ACQUIRE, "agent");
            xb_add(&bar[XB_XGEN(b.x)], 1u);
            asm volatile("s_waitcnt vmcnt(0)" ::: "memory");
        } else {
            XB_SPIN(xb_ld(&bar[XB_XGEN(b.x)]) == gen, bar);
            __builtin_amdgcn_fence(__ATOMIC_ACQUIRE, "agent");
            asm volatile("s_waitcnt vmcnt(0)" ::: "memory");
        }
    }
    __syncthreads();
}
constexpr size_t WS_BAR = 65536;
constexpr int LDS_ST_OFF = LDS_BYTES - 64;
__global__ void __launch_bounds__(NWAVES * 64, 2) fwd_kernel(Args a0) {
    extern __shared__ __attribute__((aligned(16))) unsigned char lds_raw[];
    LAS unsigned char* lds = (LAS unsigned char*)lds_raw;
    cg::grid_group grid = cg::this_grid();
    const int tid0 = threadIdx.x;
    const int wave0 = __builtin_amdgcn_readfirstlane(tid0 >> 6);
    const int G = gridDim.x, bx = blockIdx.x;
    const int NGW = G * NWAVES, gthreads = G * NWAVES * 64;
#define FRESH() int lane; asm volatile("v_mbcnt_lo_u32_b32 %0, -1, 0\n\tv_mbcnt_hi_u32_b32 %0, -1, %0" : "=v"(lane)); int wave = wave0; asm volatile("" : "+s"(wave)); const int tid = wave * 64 + lane; \
    const int gw = bx * NWAVES + wave, gtid = bx * (NWAVES * 64) + tid; (void)lane; (void)gw; (void)gtid; \
    const Args* ap_ = (const Args*)a0.ws; asm volatile("" : "+s"(ap_)); Ctx a; a.t = ap_; unsigned char* ws = a.ws(); float* X = a.out(); float* MOD = (float*)(ws + WS_MOD); bf16_t* XN = (bf16_t*)(ws + WS_XN); \
    (void)X; (void)MOD; (void)XN
    if (tid0 < 2) ((volatile LAS unsigned*)(lds + LDS_ST_OFF))[tid0] = 0u;
    __syncthreads();
    if (!MK_MULTI && tid0 == 0) (void)xb_add(&((unsigned*)(a0.ws + WS_BAR))[XB_XCNT(xb_xcc_id())], 1u);
    const int lo = a0.lo, hi = a0.hi;
#ifndef PHASE_MASK
#define PHASE_MASK 0xFFFFFFFFu
#endif
#define KON(kind) (((PHASE_MASK) >> (kind)) & 1u)
#ifndef PROBE_DUP
#define PROBE_DUP 0u
#endif
#define REPS(kind) for (int rep_ = 0; rep_ < ((((PROBE_DUP) >> (kind)) & 1u) ? 2 : 1); ++rep_)
#define RUN(k) (lo <= (k) && (k) < hi)
#define SEAM(k) do { if (RUN(k) && RUN((k) + 1)) { XcdBarrier b_; b_.bar = (unsigned*)(a0.ws + WS_BAR); b_.x = xb_xcc_id(); b_.st = (volatile LAS unsigned*)(lds + LDS_ST_OFF); xcd_barrier(b_); \
        if ((k) == 0 && a0.hi < 0) grid.sync(); } } while (0)

    if (KON(0) && RUN(0)) REPS(0) {
        const int tid = tid0, lane = tid & 63, wave = __builtin_amdgcn_readfirstlane(tid >> 6), gw = bx * NWAVES + wave;
        if (bx == 0 && tid == 0) { Args* t = (Args*)a0.ws;
#pragma unroll
            for (int k = 0; k < 32; ++k) t->in[k] = a0.in[k];
            t->out = a0.out; t->ws = a0.ws; t->lo = 0; t->hi = 0; }
        { float* rs = (float*)(a0.ws + WS_ROWSS); for (int e = bx * (NWAVES * 64) + tid; e < 9 * NTOK; e += gthreads) rs[e] = 0.f; }
        p0_prologue(a0, lds, gw, NGW, wave, lane); }
    SEAM(0);
    if (KON(1) && RUN(1)) REPS(1) { FRESH();
        const float* MODP = (const float*)(ws + WS_MODP);
        for (int e = gtid; e < 4 * 5 * 6144; e += gthreads) { const int l = e / 30720, rem = e % 30720, n = rem % 6144;
            float s = a.in(I_ADAB)[l * 6144 + n];
#pragma unroll
            for (int kc = 0; kc < 16; ++kc) s += MODP[(size_t)kc * (4 * 5 * 6144) + e];
            MOD[e] = s; }
    }
    SEAM(1);
    float* ROWSS = (float*)(a0.ws + WS_ROWSS); float* GAIN = (float*)(a0.ws + WS_GAIN); float* SHW = (float*)(a0.ws + WS_SHW);
    if (KON(2) && RUN(2)) REPS(2) { FRESH();
        { const float* xp_ = a.in(I_XP); const float* xs_ = a.in(I_XS); const float* nw_ = a.in(I_N1W);
            auto rowp = [&](int r) { return r < NCTX ? xp_ + (size_t)r * D : xs_ + (size_t)(r - NCTX) * D; };
            f32x4 cur[4], nxt[4], nwv[4];
#pragma unroll
            for (int q = 0; q < 4; ++q) { cur[q] = ((const f32x4*)rowp(gw) + lane)[64 * q]; nwv[q] = *(const f32x4*)(nw_ + 4 * lane + 256 * q); }
            for (int r = gw; r < NTOK; r += NGW) { const int cnd = cond_of_row(r);
                const int rn = (r + NGW < NTOK) ? r + NGW : r;
#pragma unroll
                for (int q = 0; q < 4; ++q) nxt[q] = ((const f32x4*)rowp(rn) + lane)[64 * q];
                float ss = 0.f; unsigned long long* o8 = (unsigned long long*)(XN + (size_t)r * D) + lane;
#pragma unroll
                for (int q = 0; q < 4; ++q) { const f32x4 v = cur[q]; ss += (v.x * v.x + v.y * v.y) + (v.z * v.z + v.w * v.w);
                    const f32x4 o = v * nwv[q] * (*(const f32x4*)(MOD + cnd * 6144 + 1024 + 4 * lane + 256 * q) + 1.f);
                    o8[64 * q] = (unsigned long long)pk2(o.x, o.y) | ((unsigned long long)pk2(o.z, o.w) << 32); }
                ss = wave_sum(ss, lane); if (lane == 0) ROWSS[r] = ss;
#pragma unroll
                for (int q = 0; q < 4; ++q) cur[q] = nxt[q]; } }
        for (int e = gtid; e < 7 * 5 * D; e += gthreads) { const int n = 1 + e / (5 * D), cnd = (e / D) % 5, col = e % D, li = n >> 1;
            const float wv = (n & 1) ? a.in(I_N2W)[li * D + col] : a.in(I_N1W)[li * D + col];
            GAIN[(size_t)(n * 5 + cnd) * D + col] = wv * (1.f + MOD[(size_t)(li * 5 + cnd) * 6144 + ((n & 1) ? 4096 : 1024) + col]); }
        { const int n = gw & 7, li = n >> 1, jj = li >> 1, wsub = gw >> 3, nsub = NGW >> 3;
            const int N = (n & 1) ? FF : ((li & 1) ? RET_IN : HY_IN);
            const bf16_t* Wt = (n & 1) ? (const bf16_t*)(ws + WS_W1) + (size_t)li * D * FF : ((li & 1) ? (const bf16_t*)(ws + WS_RETIN) + (size_t)jj * D * RET_IN : (const bf16_t*)(ws + WS_HYIN) + (size_t)jj * D * HY_IN);
            const float* shb = MOD + (size_t)li * 5 * 6144 + ((n & 1) ? 3072 : 0) + 16 * lane;
            f32x4 sh[5][4];
#pragma unroll
            for (int cnd = 0; cnd < 5; ++cnd)
#pragma unroll
                for (int q = 0; q < 4; ++q) sh[cnd][q] = *(const f32x4*)(shb + cnd * 6144 + 4 * q);
            for (int c0 = wsub; c0 < N; c0 += 8 * nsub) {
                u32x4 wv[8][2];
#pragma unroll
                for (int cc = 0; cc < 8; ++cc) { const int col = c0 + cc * nsub; const int cl = col < N ? col : c0; wv[cc][0] = *(const u32x4*)(Wt + (size_t)cl * D + 16 * lane); wv[cc][1] = *(const u32x4*)(Wt + (size_t)cl * D + 16 * lane + 8); }
#pragma unroll
                for (int cc = 0; cc < 8; ++cc) { const int col = c0 + cc * nsub; if (col >= N) break;
                    const u32x4 w0 = wv[cc][0], w1 = wv[cc][1];
                    const float wf[16] = {bflo(w0.x), bfhi(w0.x), bflo(w0.y), bfhi(w0.y), bflo(w0.z), bfhi(w0.z), bflo(w0.w), bfhi(w0.w), bflo(w1.x), bfhi(w1.x), bflo(w1.y), bfhi(w1.y), bflo(w1.z), bfhi(w1.z), bflo(w1.w), bfhi(w1.w)};
                    float dsum[5];
#pragma unroll
                    for (int cnd = 0; cnd < 5; ++cnd) { float d = 0.f;
#pragma unroll
                        for (int q = 0; q < 4; ++q) d += (sh[cnd][q].x * wf[4 * q] + sh[cnd][q].y * wf[4 * q + 1]) + (sh[cnd][q].z * wf[4 * q + 2] + sh[cnd][q].w * wf[4 * q + 3]);
                        dsum[cnd] = wave_sum(d, lane); }
                    if (lane == 0) {
#pragma unroll
                        for (int cnd = 0; cnd < 5; ++cnd) SHW[(size_t)(n * 5 + cnd) * 6144 + col] = dsum[cnd]; } } } }
    }
    SEAM(2);
    for (int i = 0; i < DEPTH; ++i) {
        const int pb = 3 + 7 * i, j = i >> 1;
#define modl (MOD + (size_t)i * 5 * 6144)
        if ((i & 1) == 0) {
            if (KON(3) && RUN(pb + 0)) REPS(3) { FRESH(); pg8::Gemm g{XN, (const bf16_t*)(ws + WS_HYIN) + (size_t)j * D * HY_IN, NTOK, HY_IN, D, D}; pg8::StaticOrder S; S.init(NTOK, HY_IN, G, bx);
                Epi<0> E{}; E.O = (bf16_t*)(ws + WS_A); E.ldc = HY_IN; E.rowss = ROWSS + (size_t)(2 * i) * NTOK; E.shw = SHW + (size_t)(2 * i) * 5 * 6144; pg8::gemm_phase(lds, g, S, E, tid); }
            SEAM(pb + 0);
            if (KON(4) && RUN(pb + 1)) REPS(4) { FRESH();
                LAS unsigned char* wl = lds + wave * 16896;
                s5_phase_full(a, j, 0, wl, gw, NGW, lane);
                for (int u = gw; u < 2048; u += NGW) s5_local_unit(a, j, u >> 6, (u >> 1) & 31, u & 1, wl, lane);
                conv_part(a, j, gtid, gthreads);
            }
            SEAM(pb + 1);
            if (KON(5) && RUN(pb + 2)) REPS(5) { FRESH();
                LAS unsigned char* wl = lds + wave * 16896;
                s5_phase_full(a, j, 32, wl, gw, NGW, lane);
            }
            SEAM(pb + 2);
            if (KON(6) && RUN(pb + 3)) REPS(6) { FRESH(); pg8::Gemm g{(const bf16_t*)(ws + WS_A + A_Z), (const bf16_t*)(ws + WS_GLU) + (size_t)j * 512 * 512, NTOK, 512, 512, 512}; pg8::StaticOrder S; S.init(NTOK, 512, G, bx);
                Epi<3> E{}; E.O = (bf16_t*)(ws + WS_A + A_MIX); E.ldc = D; E.bias = a.in(I_GLUB) + j * 512; E.Zp = (const bf16_t*)(ws + WS_A + A_Z); E.ldz = 512; pg8::gemm_phase(lds, g, S, E, tid); }
            SEAM(pb + 3);
            if (KON(7) && RUN(pb + 4)) REPS(7) { FRESH(); pg8::Gemm g{(const bf16_t*)(ws + WS_A + A_MIX), (const bf16_t*)(ws + WS_HYOUT) + (size_t)j * D * D, NTOK, D, D, D}; pg8::StaticOrder S; S.init(NTOK, D, G, bx);
                Epi<4> E{}; E.base0 = (i == 0) ? a.in(I_XP) : X; E.base1 = (i == 0) ? a.in(I_XS) : X + (size_t)NCTX * D; E.out = X; E.gate = modl + 2048;
                E.xn = XN; E.gain = GAIN + (size_t)(2 * i + 1) * 5 * D; E.rowss_out = ROWSS + (size_t)(2 * i + 1) * NTOK; pg8::gemm_phase(lds, g, S, E, tid); }
            SEAM(pb + 4);
        } else {
            if (KON(8) && RUN(pb + 0)) REPS(8) { FRESH(); pg8::Gemm g{XN, (const bf16_t*)(ws + WS_RETIN) + (size_t)j * D * RET_IN, NTOK, RET_IN, D, D}; pg8::StaticOrder S; S.init(NTOK, RET_IN, G, bx);
                Epi<2> E{}; E.O = (bf16_t*)(ws + WS_A); E.ldc = RET_IN; E.rowss = ROWSS + (size_t)(2 * i) * NTOK; E.shw = SHW + (size_t)(2 * i) * 5 * 6144; pg8::gemm_phase(lds, g, S, E, tid); }
            SEAM(pb + 0);
            if (KON(9) && RUN(pb + 1)) REPS(9) { FRESH();
                for (int u = bx; u < 512; u += G) ret_state_unit(a, j, u >> 3, u & 7, lds, wave, lane);
                CFENCE();
                for (int u = bx; u < 256; u += G) ret_out_unit(a, j, u >> 3, u & 7, lds, wave, lane);
            }
            SEAM(pb + 1);
            if (KON(10) && RUN(pb + 2)) REPS(10) { FRESH(); ret_prefix(a, j, gtid, gthreads); }
            SEAM(pb + 2);
            if (KON(11) && RUN(pb + 3)) REPS(11) { FRESH(); for (int u = bx; u < 256; u += G) ret_out_unit(a, j, 32 + (u >> 3), u & 7, lds, wave, lane); }
            SEAM(pb + 3);
            if (KON(12) && RUN(pb + 4)) REPS(12) { FRESH(); pg8::Gemm g{(const bf16_t*)(ws + WS_A + A_OG), (const bf16_t*)(ws + WS_RETOUT) + (size_t)j * 2048 * D, NTOK, D, 2048, 2048}; pg8::StaticOrder S; S.init(NTOK, D, G, bx);
                Epi<4> E{}; E.base0 = X; E.base1 = X + (size_t)NCTX * D; E.out = X; E.gate = modl + 2048;
                E.xn = XN; E.gain = GAIN + (size_t)(2 * i + 1) * 5 * D; E.rowss_out = ROWSS + (size_t)(2 * i + 1) * NTOK; pg8::gemm_phase(lds, g, S, E, tid); }
            SEAM(pb + 4);
        }
        if (KON(13) && RUN(pb + 5)) REPS(13) { FRESH(); pg8::Gemm g{XN, (const bf16_t*)(ws + WS_W1) + (size_t)i * D * FF, NTOK, FF, D, D}; pg8::StaticOrder S; S.init(NTOK, FF, G, bx);
            Epi<1> E{}; E.O = (bf16_t*)(ws + WS_A); E.ldc = FF; E.rowss = ROWSS + (size_t)(2 * i + 1) * NTOK; E.shw = SHW + (size_t)(2 * i + 1) * 5 * 6144; pg8::gemm_phase(lds, g, S, E, tid); }
        SEAM(pb + 5);
        if (KON(14) && RUN(pb + 6)) REPS(14) { FRESH(); pg8::Gemm g{(const bf16_t*)(ws + WS_A), (const bf16_t*)(ws + WS_W2) + (size_t)i * FF * D, NTOK, D, FF, FF}; pg8::StaticOrder S; S.init(NTOK, D, G, bx);
            Epi<4> E{}; E.base0 = X; E.base1 = X + (size_t)NCTX * D; E.out = X; E.gate = modl + 5120;
            E.xn = XN; E.gain = (i < DEPTH - 1) ? GAIN + (size_t)(2 * i + 2) * 5 * D : nullptr; E.rowss_out = ROWSS + (size_t)(2 * i + 2) * NTOK; pg8::gemm_phase(lds, g, S, E, tid); }
        SEAM(pb + 6);
    }
    if (KON(15) && RUN(31)) REPS(15) { FRESH();
        const float* fw = a.in(I_FNW);
        f32x4 fwv[4], v[4], nxt[4];
#pragma unroll
        for (int q = 0; q < 4; ++q) { fwv[q] = *(const f32x4*)(fw + 4 * lane + 256 * q); v[q] = ((const f32x4*)(X + (size_t)gw * D) + lane)[64 * q]; }
        for (int r = gw; r < NTOK; r += NGW) {
            f32x4* xr = (f32x4*)(X + (size_t)r * D) + lane;
            const int rn = (r + NGW < NTOK) ? r + NGW : r;
#pragma unroll
            for (int q = 0; q < 4; ++q) nxt[q] = ((const f32x4*)(X + (size_t)rn * D) + lane)[64 * q];
            const float rstd = 1.f / sqrtf(ROWSS[(size_t)8 * NTOK + r] * (1.f / D) + EPS);
#pragma unroll
            for (int q = 0; q < 4; ++q) xr[64 * q] = v[q] * rstd * fwv[q];
#pragma unroll
            for (int q = 0; q < 4; ++q) v[q] = nxt[q];
        }
    }
#undef RUN
#undef modl
#undef FRESH
#undef KON
#undef SEAM
}
constexpr int N_PHASES = 32;

extern "C" void kernel_launch(void* const* d_in, const int* in_sizes, int n_in, void* d_out, int out_size, void* d_ws, size_t ws_size, hipStream_t stream) {
    static int grid = 0;
    if (grid == 0) {
        if (n_in != 32 || ws_size < WS_END) { fprintf(stderr, "kernel_launch: unexpected n_in %d / ws_size %zu\n", n_in, ws_size); grid = -1; return; }
        int dev = 0, cus = 0, per_cu = 0;
        (void)hipGetDevice(&dev); (void)hipDeviceGetAttribute(&cus, hipDeviceAttributeMultiprocessorCount, dev);
        if (hipFuncSetAttribute((const void*)fwd_kernel, hipFuncAttributeMaxDynamicSharedMemorySize, LDS_BYTES) != hipSuccess) { fprintf(stderr, "kernel_launch: hipFuncSetAttribute failed\n"); grid = -1; return; }
        (void)hipOccupancyMaxActiveBlocksPerMultiprocessor(&per_cu, (const void*)fwd_kernel, NWAVES * 64, LDS_BYTES);
        (void)hipGetLastError();
        if (per_cu < 1) fprintf(stderr, "kernel_launch: occupancy query says %d\n", per_cu);
        grid = cus > 0 ? cus : 256;
    }
    if (grid < 0) return;
    Args a{};
    for (int i = 0; i < 32; ++i) a.in[i] = (const float*)d_in[i];
    a.out = (float*)d_out; a.ws = (unsigned char*)d_ws;
#if MK_MULTI
    for (int p = 0; p < N_PHASES; ++p) { a.lo = p; a.hi = p + 1; hipLaunchKernelGGL(fwd_kernel, dim3(grid), dim3(NWAVES * 64), LDS_BYTES, stream, a); }
#else
    a.lo = 0; a.hi = N_PHASES;
    if (hipMemsetAsync((char*)d_ws + WS_BAR, 0, XCD_BAR_WORDS * 4, stream) != hipSuccess) { fprintf(stderr, "kernel_launch: memset failed\n"); return; }
    void* args[] = {&a};
    hipError_t e = hipLaunchCooperativeKernel((const void*)fwd_kernel, dim3(grid), dim3(NWAVES * 64), args, LDS_BYTES, stream);
    if (e != hipSuccess) fprintf(stderr, "cooperative launch failed: %s (grid %d)\n", hipGetErrorString(e), grid);
#endif
}
```

```cpp
#include <hip/hip_runtime.h>
#include <hip/hip_cooperative_groups.h>
#include <cstdio>
#include <cstdint>
namespace cg = cooperative_groups;

#ifndef MK_MULTI
#define MK_MULTI 0
#endif

#define DI __device__ __forceinline__
#define LAS __attribute__((address_space(3)))
typedef unsigned short bf16_t;
typedef short bf16x8 __attribute__((ext_vector_type(8)));
typedef short s16x4 __attribute__((ext_vector_type(4)));
typedef float f32x4 __attribute__((ext_vector_type(4)));
typedef float f32x16 __attribute__((ext_vector_type(16)));
typedef unsigned u32x4 __attribute__((ext_vector_type(4)));
typedef unsigned u32x2 __attribute__((ext_vector_type(2)));

constexpr int D = 1024, NTOK = 16384, NCTX = 8192, DEPTH = 4;
constexpr int HY_IN = 2048, RET_IN = 6144, FF = 4096;
constexpr float EPS = 1e-6f;
constexpr int NWAVES = 8;
constexpr int LDS_BYTES = 147456;
enum { I_XP = 0, I_XS, I_S5RE, I_S5IM, I_SRET, I_C, I_CCTX, I_N1W, I_N2W, I_ADAW, I_ADAB, I_HYIN, I_HYOUT, I_LAMRE, I_LAMIM, I_LOGSTEP,
       I_BRE, I_BIM, I_CRE, I_CIM, I_S5D, I_GLUW, I_GLUB, I_CONVW, I_CONVB, I_RETIN, I_RETOUT, I_GAMMA, I_GNW, I_W1, I_W2, I_FNW };
constexpr size_t O_S5RE = 16777216, O_S5IM = 16777216 + 262144, O_RET = 16777216 + 2 * 262144;
constexpr size_t MiB = 1u << 20;
constexpr size_t WS_MODP = 1 * MiB, WS_MOD = 9 * MiB, WS_LOC = 10 * MiB;
constexpr size_t WS_ROWSS = 377 * MiB, WS_GAIN = 378 * MiB, WS_SHW = 379 * MiB;

constexpr size_t WS_HYIN = 12 * MiB, WS_HYOUT = 20 * MiB, WS_GLU = 24 * MiB, WS_RETIN = 25 * MiB, WS_RETOUT = 49 * MiB, WS_W1 = 57 * MiB, WS_W2 = 89 * MiB;
constexpr size_t WS_XN = 121 * MiB, WS_A = 153 * MiB, WS_LOCAL = 345 * MiB, WS_END = 380 * MiB;
constexpr size_t A_YF = 64 * MiB, A_Z = 96 * MiB, A_MIX = 112 * MiB, A_YB = 144 * MiB, A_UB = 176 * MiB;
constexpr size_t A_OG = 128 * MiB;
constexpr int QKV_LD = 512;

struct Args { const float* in[32]; float* out; unsigned char* ws; int lo, hi; };
struct Ctx { const Args* t;
    __device__ __forceinline__ const float* in(int k) const { unsigned long long r; asm volatile("s_load_dwordx2 %0, %1, %2\n\ts_waitcnt lgkmcnt(0)" : "=s"(r) : "s"(t), "s"(k * 8) : "memory"); return (const float*)(const __attribute__((address_space(1))) float*)r; }
    __device__ __forceinline__ float* out() const { unsigned long long r; asm volatile("s_load_dwordx2 %0, %1, 0x100\n\ts_waitcnt lgkmcnt(0)" : "=s"(r) : "s"(t) : "memory"); return (float*)(__attribute__((address_space(1))) float*)r; }
    __device__ __forceinline__ unsigned char* ws() const { return (unsigned char*)(__attribute__((address_space(1))) unsigned char*)(unsigned long long)t; } };

typedef float f32x2_ __attribute__((ext_vector_type(2)));
typedef __bf16 bf16x2_ __attribute__((ext_vector_type(2)));
DI unsigned pk2(float lo, float hi) { const f32x2_ v = {lo, hi}; return __builtin_bit_cast(unsigned, __builtin_convertvector(v, bf16x2_)); }
DI unsigned f2bf(float f) { return pk2(f, 0.f) & 0xffffu; }
DI unsigned cvt_pk_bf16(float lo, float hi) { unsigned r; asm volatile("v_cvt_pk_bf16_f32 %0, %1, %2" : "=v"(r) : "v"(lo), "v"(hi)); return r; }
DI float bf2f(unsigned b) { return __builtin_bit_cast(float, b << 16); }
DI float bflo(unsigned w) { return __builtin_bit_cast(float, w << 16); }
DI float bfhi(unsigned w) { return __builtin_bit_cast(float, w & 0xffff0000u); }
DI float shfl_xor_l(float v, int o, int lane) { return __builtin_bit_cast(float, __builtin_amdgcn_ds_bpermute((lane ^ o) << 2, __builtin_bit_cast(int, v))); }
DI float wave_sum(float v, int lane) {
#pragma unroll
    for (int o = 1; o < 64; o <<= 1) v += shfl_xor_l(v, o, lane);
    return v;
}
DI int crow(int reg, int h) { return (reg & 3) + 8 * (reg >> 2) + 4 * h; }
DI float sigmoidf_(float x) { return __builtin_amdgcn_rcpf(1.f + __expf(-x)); }
DI float siluf_(float x) { return x * sigmoidf_(x); }
DI float gelu_tanh(float x) { const float u = 0.7978845608028654f * (x + 0.044715f * x * x * x); const float e = __expf(2.f * u); return x * (1.f - __builtin_amdgcn_rcpf(e + 1.f)); }
DI int cond_of_row(int r) { return r < NCTX ? 0 : 1 + ((r - NCTX) >> 11); }
#define MFMA32(a, b, c) __builtin_amdgcn_mfma_f32_32x32x16_bf16((a), (b), (c), 0, 0, 0)
#define MFMA16(a, b, c) __builtin_amdgcn_mfma_f32_16x16x32_bf16((a), (b), (c), 0, 0, 0)
#define LDS_WAIT() asm volatile("s_waitcnt lgkmcnt(0)" ::: "memory")
#define CFENCE() do { asm volatile("" ::: "memory"); __builtin_amdgcn_sched_barrier(0); } while (0)
#define WAVE_SYNC() do { asm volatile("s_waitcnt lgkmcnt(0)" ::: "memory"); __builtin_amdgcn_wave_barrier(); } while (0)

namespace pg8 {
constexpr int BM = 256, BK = 64, HALF = 128, HTB = HALF * BK * 2, STAGE_BYTES = 8 * HTB, NXCD = 8, WGM = 8;
DI int lds_byte(int r, int c) { const int st = (r >> 4) * 2 + (c >> 5), rr = r & 15, cc = c & 31, ob = rr * 64 + cc * 2; return st * 1024 + (ob ^ (((ob >> 9) & 1) << 5)); }
DI void stage_rc(int b, int& R, int& C) { const int st = b / 1024, sb = b % 1024, swz = sb ^ (((sb >> 9) & 1) << 5); R = (st >> 1) * 16 + swz / 64; C = (st & 1) * 32 + (swz % 64) / 2; }
DI int perm32(int rho) { const int n = rho >> 4, i = rho & 15; return 8 * (i >> 2) + 4 * n + (i & 3); }
struct Unit { int pm, pn; };
struct Gemm { const bf16_t* A; const bf16_t* Bt; int M, N, K, lda; };
struct StaticOrder {
    int nM, nN, nwg, G, c;
    DI void init(int M, int N, int G_, int c_) { nM = M / BM; nN = N / BM; nwg = nM * nN; G = G_; c = c_; }
    DI bool next(int i, Unit& u) const {
        const long L = (long)i * G + c; if (L >= nwg) return false;
        int wgid = (int)L; { const int q = nwg / NXCD, r = nwg % NXCD, xcd = wgid % NXCD, off = wgid / NXCD; wgid = (xcd < r ? xcd * (q + 1) : r * (q + 1) + (xcd - r) * q) + off; }
        const int nig = WGM * nN, gid = wgid / nig, fm = gid * WGM, gsz = (nM - fm) < WGM ? (nM - fm) : WGM;
        u.pm = fm + ((wgid % nig) % gsz); u.pn = (wgid % nig) / gsz; return true;
    }
};
template <class Epi>
DI void gemm_phase(LAS unsigned char* lds, const Gemm g, const StaticOrder& S, const Epi& E, const int tid) {
    const int wid = __builtin_amdgcn_readfirstlane(tid >> 6), lane = tid & 63, wr = wid >> 2, wc = wid & 3, fr = lane & 15, fq = lane >> 4;
    const int K = g.K, nt = K / BK, lda = g.lda;
    unsigned voffA[2], voffB[2];
#pragma unroll
    for (int i = 0; i < 2; ++i) { int R, C; stage_rc(tid * 16 + i * 8192, R, C); const int Rb = (R & ~31) + perm32(R & 31);
        voffA[i] = (unsigned)(R * lda + C) * 2u; voffB[i] = (unsigned)(Rb * K + C) * 2u; }
    const size_t kstep = (size_t)(BK * 2);
    const size_t hstepA = (size_t)HALF * lda * 2, hstepB = (size_t)HALF * K * 2;
    const size_t tstepA = 2 * hstepA, tstepB = 2 * hstepB;
    const unsigned ldsw = (unsigned)wid * 1024u;
    const int aoff = lds_byte(wr * 64 + fr, fq * 8), boff = lds_byte(wc * 32 + fr, fq * 8);
#define PG8_SA(b, h) (((b) * 2 + (h)) * HTB)
#define PG8_SB(b, h) ((4 + (b) * 2 + (h)) * HTB)
#define PG8_STAGE(bufoff, gbase, voff) do { _Pragma("unroll") for (int _i = 0; _i < 2; ++_i) \
        __builtin_amdgcn_global_load_lds((const unsigned*)((const char*)(gbase) + (voff)[_i]), (LAS unsigned*)(lds + (bufoff) + ldsw + _i * 8192), 16, 0, 0); } while (0)
#define PG8_LDA(dst, b, h) do { _Pragma("unroll") for (int m = 0; m < 4; ++m) _Pragma("unroll") for (int k = 0; k < 2; ++k) dst[m][k] = *(const LAS bf16x8*)(lds + PG8_SA(b, h) + aoff + m * 2048 + k * 1024); } while (0)
#define PG8_LDB(dst, b, h) do { _Pragma("unroll") for (int n = 0; n < 2; ++n) _Pragma("unroll") for (int k = 0; k < 2; ++k) dst[n][k] = *(const LAS bf16x8*)(lds + PG8_SB(b, h) + boff + n * 2048 + k * 1024); } while (0)
#define PG8_MMA(ai, bj, At, Bt) do { __builtin_amdgcn_s_setprio(1); _Pragma("unroll") for (int m = 0; m < 4; ++m) _Pragma("unroll") for (int n = 0; n < 2; ++n) _Pragma("unroll") for (int k = 0; k < 2; ++k) \
        acc[ai][bj][m][n] = __builtin_amdgcn_mfma_f32_16x16x32_bf16(Bt[n][k], At[m][k], acc[ai][bj][m][n], 0, 0, 0); __builtin_amdgcn_s_setprio(0); } while (0)
#define PG8_WAIT_V(n) asm volatile("s_waitcnt vmcnt(" #n ")" ::: "memory")
#define PG8_WAIT_L(n) asm volatile("s_waitcnt lgkmcnt(" #n ")" ::: "memory")
#define PG8_BAR __builtin_amdgcn_s_barrier()
#define PG8_SCHED __builtin_amdgcn_sched_barrier(0)
    Unit cur, nxt; int ui = 0;
    if (!S.next(0, cur)) return;
    f32x4 acc[2][2][4][2];
#pragma unroll
    for (int a = 0; a < 2; ++a)
#pragma unroll
        for (int b = 0; b < 2; ++b)
#pragma unroll
            for (int m = 0; m < 4; ++m)
#pragma unroll
                for (int n = 0; n < 2; ++n) acc[a][b][m][n] = (f32x4){0.f, 0.f, 0.f, 0.f};
    bf16x8 At[4][2], B0[2][2], B1[2][2];
    const char* cA = (const char*)g.A + (size_t)cur.pm * tstepA; const char* cB = (const char*)g.Bt + (size_t)cur.pn * tstepB;
    PG8_STAGE(PG8_SB(0, 0), cB, voffB); PG8_STAGE(PG8_SB(0, 1), cB + hstepB, voffB); PG8_STAGE(PG8_SA(0, 0), cA, voffA); PG8_STAGE(PG8_SA(0, 1), cA + hstepA, voffA);
    if (wr == 1) PG8_BAR;
    PG8_WAIT_V(2); PG8_BAR;
    PG8_STAGE(PG8_SB(1, 0), cB + kstep, voffB); PG8_STAGE(PG8_SA(1, 0), cA + kstep, voffA); PG8_STAGE(PG8_SB(1, 1), cB + hstepB + kstep, voffB);
    PG8_WAIT_V(6); PG8_BAR;
    for (;;) {
        const bool has_next = S.next(ui + 1, nxt);
        const char* nA = has_next ? (const char*)g.A + (size_t)nxt.pm * tstepA : cA; const char* nB = has_next ? (const char*)g.Bt + (size_t)nxt.pn * tstepB : cB;
        for (int t = 0; t < nt; t += 2) {
            const bool last = (t == nt - 2);
            const char* a1 = cA + (size_t)(t + 1) * kstep;
            const char* a2 = last ? nA : cA + (size_t)(t + 2) * kstep; const char* b2 = last ? nB : cB + (size_t)(t + 2) * kstep;
            const char* a3 = a2 + kstep; const char* b3 = b2 + kstep;
            PG8_LDB(B0, 0, 0); PG8_LDB(B1, 0, 1); PG8_SCHED; PG8_LDA(At, 0, 0); PG8_STAGE(PG8_SA(1, 1), a1 + hstepA, voffA);
            PG8_WAIT_V(8); PG8_WAIT_L(0); PG8_BAR; PG8_MMA(0, 0, At, B0); PG8_MMA(0, 1, At, B1); PG8_BAR; PG8_SCHED;
            PG8_LDA(At, 0, 1); PG8_STAGE(PG8_SB(0, 0), b2, voffB); PG8_STAGE(PG8_SB(0, 1), b2 + hstepB, voffB); PG8_STAGE(PG8_SA(0, 0), a2, voffA);
            PG8_WAIT_V(8); PG8_WAIT_L(0); PG8_BAR; PG8_MMA(1, 0, At, B0); PG8_MMA(1, 1, At, B1); PG8_BAR; PG8_SCHED;
            PG8_LDB(B0, 1, 0); PG8_LDB(B1, 1, 1); PG8_SCHED; PG8_LDA(At, 1, 0); PG8_STAGE(PG8_SA(0, 1), a2 + hstepA, voffA);
            PG8_WAIT_V(8); PG8_WAIT_L(0); PG8_BAR; PG8_MMA(0, 0, At, B0); PG8_MMA(0, 1, At, B1); PG8_BAR; PG8_SCHED;
            PG8_LDA(At, 1, 1); PG8_STAGE(PG8_SB(1, 0), b3, voffB); PG8_STAGE(PG8_SB(1, 1), b3 + hstepB, voffB); PG8_STAGE(PG8_SA(1, 0), a3, voffA);
            PG8_WAIT_V(8); PG8_WAIT_L(0); PG8_BAR; PG8_MMA(1, 0, At, B0); PG8_MMA(1, 1, At, B1); PG8_BAR; PG8_SCHED;
        }
        if (wr == 0) PG8_BAR;
        E(acc, cur, wr, wc, fr, fq);
        if (!has_next) break;
#pragma unroll
        for (int a = 0; a < 2; ++a)
#pragma unroll
            for (int b = 0; b < 2; ++b)
#pragma unroll
                for (int m = 0; m < 4; ++m)
#pragma unroll
                    for (int n = 0; n < 2; ++n) acc[a][b][m][n] = (f32x4){0.f, 0.f, 0.f, 0.f};
        cur = nxt; cA = nA; cB = nB; ++ui;
        if (wr == 1) PG8_BAR;
    }
    PG8_WAIT_V(0);
    PG8_BAR;
#undef PG8_SA
#undef PG8_SB
#undef PG8_STAGE
#undef PG8_LDA
#undef PG8_LDB
#undef PG8_MMA
#undef PG8_WAIT_V
#undef PG8_WAIT_L
#undef PG8_BAR
#undef PG8_SCHED
}
}

template <int MODE> struct Epi {
    bf16_t* O; int ldc;
    const float* rowss; const float* shw;
    bf16_t* xn; const float* gain; float* rowss_out;
    const float* bias; const bf16_t* Zp; int ldz;
    const float* base0; const float* base1; float* out; const float* gate;
    DI void operator()(const f32x4 (&acc)[2][2][4][2], const pg8::Unit& u, int wr, int wc, int fr, int fq) const {
        using namespace pg8;
        const int row0 = u.pm * BM + wr * 64 + fr, col0 = u.pn * BM + wc * 32 + 8 * fq;
        const float* shp = shw + (size_t)cond_of_row(u.pm * BM) * 6144 + col0;
        if constexpr (MODE == 0 || MODE == 1) {
            f32x4 sw[2][2];
#pragma unroll
            for (int bj = 0; bj < 2; ++bj) { sw[bj][0] = *(const f32x4*)(shp + bj * HALF); sw[bj][1] = *(const f32x4*)(shp + bj * HALF + 4); }
            float rsv[2][4];
#pragma unroll
            for (int ai = 0; ai < 2; ++ai)
#pragma unroll
                for (int m = 0; m < 4; ++m) rsv[ai][m] = rowss[row0 + ai * HALF + m * 16];
#pragma unroll
            for (int ai = 0; ai < 2; ++ai)
#pragma unroll
                for (int m = 0; m < 4; ++m) { bf16_t* rowp = O + (size_t)(row0 + ai * HALF + m * 16) * ldc + col0;
                    const float rstd = 1.f / sqrtf(rsv[ai][m] * (1.f / D) + EPS);
#pragma unroll
                    for (int bj = 0; bj < 2; ++bj) { f32x4 v0 = acc[ai][bj][m][0] * rstd + sw[bj][0], v1 = acc[ai][bj][m][1] * rstd + sw[bj][1];
                        if (MODE == 1) {
#pragma unroll
                            for (int e = 0; e < 4; ++e) { const float a = fmaxf(v0[e], 0.f), b = fmaxf(v1[e], 0.f); v0[e] = a * a; v1[e] = b * b; } }
                        u32x4 w; w.x = pk2(v0[0], v0[1]); w.y = pk2(v0[2], v0[3]); w.z = pk2(v1[0], v1[1]); w.w = pk2(v1[2], v1[3]);
                        *(u32x4*)(rowp + bj * HALF) = w; } }
        } else if constexpr (MODE == 2) {
            const bool qk = (u.pn < 8), latent = (u.pm >= 32);
            const float scale = (u.pn < 4) ? 0.08838834764831845f : 1.f;
            f32x4 sw[2][2]; float rsv[2][4];
#pragma unroll
            for (int bj = 0; bj < 2; ++bj) { sw[bj][0] = *(const f32x4*)(shp + bj * HALF); sw[bj][1] = *(const f32x4*)(shp + bj * HALF + 4); }
#pragma unroll
            for (int ai = 0; ai < 2; ++ai)
#pragma unroll
                for (int m = 0; m < 4; ++m) rsv[ai][m] = rowss[row0 + ai * HALF + m * 16];
#pragma unroll
            for (int ai = 0; ai < 2; ++ai)
#pragma unroll
                for (int m = 0; m < 4; ++m) { const int r = row0 + ai * HALF + m * 16;
                    const int t = (r - NCTX) & 2047; const int gr = t >> 6, gc = t & 63;
                    const float rstd = 1.f / sqrtf(rsv[ai][m] * (1.f / D) + EPS);
#pragma unroll
                    for (int bj = 0; bj < 2; ++bj) { f32x4 v0 = acc[ai][bj][m][0] * rstd + sw[bj][0], v1 = acc[ai][bj][m][1] * rstd + sw[bj][1];
                        if (qk) {
                            if (latent) {
                                const int c = col0 + bj * HALF;
                                const float pos = (float)(((c >> 6) & 1) ? gc : gr);
                                const int f0 = (c & 63) >> 1;
#pragma unroll
                                for (int pp = 0; pp < 4; ++pp) {
                                    const float ang = pos * __builtin_amdgcn_exp2f(-(float)(f0 + pp) * (13.287712379549449f / 32.f));
                                    const float cs = __cosf(ang), sn = __sinf(ang);
                                    float x1, x2;
                                    if (pp == 0) { x1 = v0[0]; x2 = v0[1]; } else if (pp == 1) { x1 = v0[2]; x2 = v0[3]; } else if (pp == 2) { x1 = v1[0]; x2 = v1[1]; } else { x1 = v1[2]; x2 = v1[3]; }
                                    const float y1 = x1 * cs - x2 * sn, y2 = x1 * sn + x2 * cs;
                                    if (pp == 0) { v0[0] = y1; v0[1] = y2; } else if (pp == 1) { v0[2] = y1; v0[3] = y2; } else if (pp == 2) { v1[0] = y1; v1[1] = y2; } else { v1[2] = y1; v1[3] = y2; }
                                }
                            }
                            v0 = v0 * scale; v1 = v1 * scale;
                        }
                        u32x4 w; w.x = pk2(v0[0], v0[1]); w.y = pk2(v0[2], v0[3]); w.z = pk2(v1[0], v1[1]); w.w = pk2(v1[2], v1[3]);
                        const int c = col0 + bj * HALF; bf16_t* dst;
                        if (c < 2048) { const int hd_ = (c & 1023) >> 7; dst = O + ((size_t)((r >> 8) * 8 + hd_) * 256 + (r & 255)) * QKV_LD + (c >> 10) * 128 + (c & 127); }
                        else if (c < 4096) { const int hd_ = (c - 2048) >> 8; dst = O + ((size_t)((r >> 8) * 8 + hd_) * 256 + (r & 255)) * QKV_LD + 256 + (c & 255); }
                        else dst = O + A_OG / 2 + (size_t)r * 2048 + (c - 4096);
                        *(u32x4*)dst = w; } }
        } else if constexpr (MODE == 3) {
#pragma unroll
            for (int ai = 0; ai < 2; ++ai) {
                u32x4 zwv[4][2];
#pragma unroll
                for (int m = 0; m < 4; ++m)
#pragma unroll
                    for (int bj = 0; bj < 2; ++bj) zwv[m][bj] = *(const u32x4*)(Zp + (size_t)(row0 + ai * HALF + m * 16) * ldz + col0 + bj * HALF);
#pragma unroll
                for (int m = 0; m < 4; ++m) { const int r = row0 + ai * HALF + m * 16;
#pragma unroll
                    for (int bj = 0; bj < 2; ++bj) { const int c = col0 + bj * HALF;
                        const f32x4 b0 = *(const f32x4*)(bias + c), b1 = *(const f32x4*)(bias + c + 4);
                        const u32x4 zw = zwv[m][bj];
                        f32x4 v0 = acc[ai][bj][m][0] + b0, v1 = acc[ai][bj][m][1] + b1;
                        const float z[8] = {bflo(zw.x), bfhi(zw.x), bflo(zw.y), bfhi(zw.y), bflo(zw.z), bfhi(zw.z), bflo(zw.w), bfhi(zw.w)};
#pragma unroll
                        for (int e = 0; e < 4; ++e) { v0[e] = z[e] * sigmoidf_(v0[e]); v1[e] = z[4 + e] * sigmoidf_(v1[e]); }
                        u32x4 w; w.x = pk2(v0[0], v0[1]); w.y = pk2(v0[2], v0[3]); w.z = pk2(v1[0], v1[1]); w.w = pk2(v1[2], v1[3]);
                        *(u32x4*)(O + (size_t)r * ldc + c) = w; } } }
        } else {
            const int rt = u.pm * BM;
            const float* gp = gate + (size_t)cond_of_row(rt) * 6144;
            const float* bp = rt < NCTX ? base0 : base1 - (size_t)NCTX * D;
            const float* gnp = gain ? gain + (size_t)cond_of_row(rt) * D : gp;
            float ssq[2][4];
#pragma unroll
            for (int ai = 0; ai < 2; ++ai)
#pragma unroll
                for (int m = 0; m < 4; ++m) ssq[ai][m] = 0.f;
#pragma unroll
            for (int bj = 0; bj < 2; ++bj) { const int c = col0 + bj * HALF;
                const f32x4 g0 = *(const f32x4*)(gp + c), g1 = *(const f32x4*)(gp + c + 4);
                const f32x4 gn0 = *(const f32x4*)(gnp + c), gn1 = *(const f32x4*)(gnp + c + 4);
#pragma unroll
                for (int ai = 0; ai < 2; ++ai) {
                    f32x4 x0[4], x1[4];
#pragma unroll
                    for (int m = 0; m < 4; ++m) { const size_t off = (size_t)(row0 + ai * HALF + m * 16) * D + c; x0[m] = *(const f32x4*)(bp + off); x1[m] = *(const f32x4*)(bp + off + 4); }
#pragma unroll
                    for (int m = 0; m < 4; ++m) { const size_t off = (size_t)(row0 + ai * HALF + m * 16) * D + c;
                        const f32x4 y0 = x0[m] + g0 * acc[ai][bj][m][0], y1 = x1[m] + g1 * acc[ai][bj][m][1];
                        *(f32x4*)(out + off) = y0; *(f32x4*)(out + off + 4) = y1;
                        ssq[ai][m] += (y0[0] * y0[0] + y0[1] * y0[1]) + (y0[2] * y0[2] + y0[3] * y0[3]) + (y1[0] * y1[0] + y1[1] * y1[1]) + (y1[2] * y1[2] + y1[3] * y1[3]);
                        if (gain) { const f32x4 z0 = y0 * gn0, z1 = y1 * gn1; u32x4 w; w.x = pk2(z0[0], z0[1]); w.y = pk2(z0[2], z0[3]); w.z = pk2(z1[0], z1[1]); w.w = pk2(z1[2], z1[3]); *(u32x4*)(xn + off) = w; } } } }
            const int lane_ = fr + 16 * fq;
#pragma unroll
            for (int ai = 0; ai < 2; ++ai)
#pragma unroll
                for (int m = 0; m < 4; ++m) { float v = ssq[ai][m]; v += shfl_xor_l(v, 16, lane_); v += shfl_xor_l(v, 32, lane_);
                    if (fq == 0) atomicAdd(rowss_out + row0 + ai * HALF + m * 16, v); }
        }
    }
};

template <bool RPERM>
DI void p0_transpose_item(const float* W, int K, int N, bf16_t* WT, LAS float* scr, int item, int lane) {
    const int nblk = N / 32, kb = item / nblk, nb = item % nblk, k0 = 64 * kb, n0 = 32 * nb;
#pragma unroll 8
    for (int i = 0; i < 32; ++i) { const int kk = 2 * i + (lane >> 5); scr[kk * 33 + (lane & 31)] = W[(size_t)(k0 + kk) * N + n0 + (lane & 31)]; }
    LDS_WAIT();
    const int c = lane & 7;
#pragma unroll
    for (int j = 0; j < 4; ++j) { const int n = (lane >> 3) + 8 * j; const LAS float* s = scr + (8 * c) * 33 + n;
        u32x4 o; o.x = pk2(s[0 * 33], s[1 * 33]); o.y = pk2(s[2 * 33], s[3 * 33]); o.z = pk2(s[4 * 33], s[5 * 33]); o.w = pk2(s[6 * 33], s[7 * 33]);
        int nd = n0 + n;
        if (RPERM && nd < 2048) { const int f = nd & 31, s2 = (nd >> 5) & 1; nd = (nd & ~63) + 2 * f + s2; }
        *(u32x4*)(WT + (size_t)nd * K + k0 + 8 * c) = o; }
    LDS_WAIT();
}

DI void p0_prologue(const Args& a, LAS unsigned char* lds, int gw, int NGW, int wave, int lane) {
    LAS float* scr = (LAS float*)(lds + wave * 16384);
    unsigned char* ws = a.ws;
    constexpr int IT_HYIN = (D / 64) * (HY_IN / 32), IT_HYOUT = (D / 64) * (D / 32), IT_GLU = (512 / 64) * (512 / 32), IT_RETIN = (D / 64) * (RET_IN / 32),
                  IT_RETOUT = (2048 / 64) * (D / 32), IT_W1 = (D / 64) * (FF / 32), IT_W2 = (FF / 64) * (D / 32);
    constexpr int NIT = 2 * (IT_HYIN + IT_HYOUT + IT_GLU + IT_RETIN + IT_RETOUT) + 4 * (IT_W1 + IT_W2);
    for (int it = gw; it < NIT; it += NGW) {
        int r = it;
        if (r < 2 * IT_HYIN) { const int j = r / IT_HYIN; p0_transpose_item<false>(a.in[I_HYIN] + (size_t)j * D * HY_IN, D, HY_IN, (bf16_t*)(ws + WS_HYIN) + (size_t)j * D * HY_IN, scr, r % IT_HYIN, lane); continue; } r -= 2 * IT_HYIN;
        if (r < 2 * IT_HYOUT) { const int j = r / IT_HYOUT; p0_transpose_item<false>(a.in[I_HYOUT] + (size_t)j * D * D, D, D, (bf16_t*)(ws + WS_HYOUT) + (size_t)j * D * D, scr, r % IT_HYOUT, lane); continue; } r -= 2 * IT_HYOUT;
        if (r < 2 * IT_GLU) { const int j = r / IT_GLU; p0_transpose_item<false>(a.in[I_GLUW] + (size_t)j * 512 * 512, 512, 512, (bf16_t*)(ws + WS_GLU) + (size_t)j * 512 * 512, scr, r % IT_GLU, lane); continue; } r -= 2 * IT_GLU;
        if (r < 2 * IT_RETIN) { const int j = r / IT_RETIN; p0_transpose_item<true>(a.in[I_RETIN] + (size_t)j * D * RET_IN, D, RET_IN, (bf16_t*)(ws + WS_RETIN) + (size_t)j * D * RET_IN, scr, r % IT_RETIN, lane); continue; } r -= 2 * IT_RETIN;
        if (r < 2 * IT_RETOUT) { const int j = r / IT_RETOUT; p0_transpose_item<false>(a.in[I_RETOUT] + (size_t)j * 2048 * D, 2048, D, (bf16_t*)(ws + WS_RETOUT) + (size_t)j * 2048 * D, scr, r % IT_RETOUT, lane); continue; } r -= 2 * IT_RETOUT;
        if (r < 4 * IT_W1) { const int j = r / IT_W1; p0_transpose_item<false>(a.in[I_W1] + (size_t)j * D * FF, D, FF, (bf16_t*)(ws + WS_W1) + (size_t)j * D * FF, scr, r % IT_W1, lane); continue; } r -= 4 * IT_W1;
        { const int j = r / IT_W2; p0_transpose_item<false>(a.in[I_W2] + (size_t)j * FF * D, FF, D, (bf16_t*)(ws + WS_W2) + (size_t)j * FF * D, scr, r % IT_W2, lane); }
    }
    float* MODP = (float*)(ws + WS_MODP);
    for (int it = gw; it < 16 * 4 * 24; it += NGW) {
        const int nb = it % 24, l = (it / 24) & 3, kc = it / 96, k0 = kc * 64, col0 = nb * 256 + 4 * lane;
        float scv[5];
        { const float v = a.in[I_CCTX][k0 + lane]; scv[0] = siluf_(v); }
#pragma unroll
        for (int cnd = 1; cnd < 5; ++cnd) { const float v = a.in[I_C][(cnd - 1) * D + k0 + lane]; scv[cnd] = siluf_(v); }
        f32x4 acc[5];
#pragma unroll
        for (int cnd = 0; cnd < 5; ++cnd) acc[cnd] = (f32x4){0.f, 0.f, 0.f, 0.f};
        const float* wp = a.in[I_ADAW] + ((size_t)l * D + k0) * 6144 + col0;
#pragma unroll 8
        for (int kk = 0; kk < 64; ++kk) { const f32x4 w4 = *(const f32x4*)(wp + (size_t)kk * 6144);
#pragma unroll
            for (int cnd = 0; cnd < 5; ++cnd) { const float s = __shfl(scv[cnd], kk); acc[cnd] += w4 * s; } }
#pragma unroll
        for (int cnd = 0; cnd < 5; ++cnd) *(f32x4*)(MODP + ((size_t)((kc * 4 + l) * 5 + cnd)) * 6144 + col0) = acc[cnd];
    }
}

DI void norm_row_bf16(const f32x4 (&v)[4], bf16_t* orow, const float* w, const float* sc, const float* sh, int lane) {
    float s = 0.f;
#pragma unroll
    for (int j = 0; j < 4; ++j) { s += (v[j].x * v[j].x + v[j].y * v[j].y) + (v[j].z * v[j].z + v[j].w * v[j].w); }
    const float rstd = 1.f / sqrtf(wave_sum(s, lane) * (1.f / D) + EPS);
    unsigned long long* o8 = (unsigned long long*)orow + lane;
#pragma unroll
    for (int j = 0; j < 4; ++j) { const int c = 4 * lane + 256 * j; const f32x4 ww = *(const f32x4*)(w + c), cc = *(const f32x4*)(sc + c), hh = *(const f32x4*)(sh + c);
        const f32x4 o = v[j] * rstd * ww * (cc + 1.f) + hh;
        o8[64 * j] = (unsigned long long)pk2(o.x, o.y) | ((unsigned long long)pk2(o.z, o.w) << 32); }
}

struct S5C { float are, aim; bf16x8 bfrag[4]; bf16x8 cfrag[4]; };
DI void s5_consts(const Ctx& a, int j, int dir, int g, int lane, S5C& k, bool need_c) {
    const int l32 = lane & 31, h = lane >> 5;
    const int gi = (j * 2 + dir) * 32 + g; const size_t pidx = (size_t)gi * 64;
    const float dt = expf(a.in(I_LOGSTEP)[gi]);
    const float* lamre_ = a.in(I_LAMRE); const float* lamim_ = a.in(I_LAMIM); const float* bre_ = a.in(I_BRE); const float* bim_ = a.in(I_BIM);
#pragma unroll
    for (int pp = 0; pp < 2; ++pp) { const int p = pp * 32 + l32;
        const float lr = lamre_[pidx + p], li = lamim_[pidx + p]; const float mag = expf(lr * dt); const float abr = mag * cosf(li * dt), abi = mag * sinf(li * dt);
        if (pp == h) { k.are = abr; k.aim = abi; }
        const float den = lr * lr + li * li; const float fre = ((abr - 1.f) * lr + abi * li) / den, fim = (abi * lr - (abr - 1.f) * li) / den;
        const f32x4* br = (const f32x4*)(bre_ + (pidx + p) * 16 + 8 * h); const f32x4* bi = (const f32x4*)(bim_ + (pidx + p) * 16 + 8 * h);
        const f32x4 r0 = br[0], r1 = br[1], i0 = bi[0], i1 = bi[1];
        const float bre[8] = {r0.x, r0.y, r0.z, r0.w, r1.x, r1.y, r1.z, r1.w}, bim[8] = {i0.x, i0.y, i0.z, i0.w, i1.x, i1.y, i1.z, i1.w};
#pragma unroll
        for (int i = 0; i < 8; ++i) { k.bfrag[pp][i] = (short)f2bf(fre * bre[i] - fim * bim[i]); k.bfrag[2 + pp][i] = (short)f2bf(fre * bim[i] + fim * bre[i]); } }
    if (need_c) { const int c = lane & 15, kq = lane >> 4;
        const float* cre_ = a.in(I_CRE); const float* cim_ = a.in(I_CIM);
#pragma unroll
        for (int ks = 0; ks < 4; ++ks) { const int p0 = ks * 16 + kq * 4;
            const f32x4 cr = *(const f32x4*)(cre_ + ((size_t)gi * 16 + c) * 64 + p0), ci = *(const f32x4*)(cim_ + ((size_t)gi * 16 + c) * 64 + p0);
            k.cfrag[ks][0] = (short)f2bf(cr.x); k.cfrag[ks][1] = (short)f2bf(-ci.x); k.cfrag[ks][2] = (short)f2bf(cr.y); k.cfrag[ks][3] = (short)f2bf(-ci.y);
            k.cfrag[ks][4] = (short)f2bf(cr.z); k.cfrag[ks][5] = (short)f2bf(-ci.z); k.cfrag[ks][6] = (short)f2bf(cr.w); k.cfrag[ks][7] = (short)f2bf(-ci.w); } }
}
template <bool FULL>
DI void s5_scan256(const S5C& k, int dir, int g, int r0, float& xr, float& xi, LAS unsigned char* wl, const bf16_t* PROJ, float* Y, int lane) {
    const int l32 = lane & 31, h = lane >> 5;
    LAS float* wf = (LAS float*)wl;
    f32x16 zero; for (int i = 0; i < 16; ++i) zero[i] = 0.f;
    auto tok = [&](int s) { return dir ? 255 - s : s; };
    bf16x8 uf = *(const bf16x8*)(PROJ + (size_t)(r0 + tok(l32)) * HY_IN + g * 16 + 8 * h);
    for (int q = 0; q < 8; ++q) {
        bf16x8 ufn = uf;
        if (q < 7) ufn = *(const bf16x8*)(PROJ + (size_t)(r0 + tok(32 * (q + 1) + l32)) * HY_IN + g * 16 + 8 * h);
#pragma unroll
        for (int pp = 0; pp < 2; ++pp) { const f32x16 are_ = MFMA32(uf, k.bfrag[pp], zero), aim_ = MFMA32(uf, k.bfrag[2 + pp], zero);
#pragma unroll
            for (int i = 0; i < 16; ++i) { typedef float f32x2 __attribute__((ext_vector_type(2))); *(LAS f32x2*)(wf + crow(i, h) * 132 + 2 * (pp * 32 + l32)) = (f32x2){are_[i], aim_[i]}; } }
        WAVE_SYNC();
#pragma unroll 1
        for (int m0 = 0; m0 < 32; m0 += 8) {
            typedef float f32x2 __attribute__((ext_vector_type(2)));
            f32x2 b[8];
#pragma unroll
            for (int i = 0; i < 8; ++i) b[i] = *(const LAS f32x2*)(wf + (m0 + i) * 132 + 2 * lane);
            asm volatile("s_waitcnt lgkmcnt(0)" ::: "memory");
            {
                f32x2 xv = {xr, xi}; const f32x2 a1 = {k.are, k.are}, a2 = {-k.aim, k.aim};
#pragma unroll
                for (int i = 0; i < 8; ++i) {
                    xv = a1 * xv + (a2 * __builtin_shufflevector(xv, xv, 1, 0) + b[i]);
                    if (FULL) *(LAS unsigned*)(wl + (m0 + i) * 528 + 4 * lane) = cvt_pk_bf16(xv.x, xv.y);
                }
                xr = xv.x; xi = xv.y; }
        }
        if (FULL) {
            WAVE_SYNC();
            const int c = lane & 15, kq = lane >> 4;
#pragma unroll
            for (int tt = 0; tt < 2; ++tt) { f32x4 y = (f32x4){0.f, 0.f, 0.f, 0.f};
#pragma unroll
                for (int ks = 0; ks < 4; ++ks) { const bf16x8 af = *(const LAS bf16x8*)(wl + (tt * 16 + c) * 528 + (ks * 32 + kq * 8) * 2); y = MFMA16(af, k.cfrag[ks], y); }
#pragma unroll
                for (int r = 0; r < 4; ++r) { const int row = r0 + tok(32 * q + tt * 16 + 4 * kq + r); Y[(size_t)row * 512 + g * 16 + c] = y[r]; } }
            WAVE_SYNC();
        }
        uf = ufn;
    }
}
DI void s5_full_dir(const Ctx& a, int j, int sc, int g, int dir, LAS unsigned char* wl, int lane) {
    unsigned char* ws = a.ws(); const bf16_t* PROJ = (const bf16_t*)(ws + WS_A); float* Y = (float*)(ws + WS_A + (dir ? A_YB : A_YF));
    const float* LOC = (const float*)(ws + WS_LOC);
    const int r0 = sc * 256; const bool latent = sc >= 32; const int lb = (sc - 32) >> 3, lc = (sc - 32) & 7;
    S5C k; s5_consts(a, j, dir, g, lane, k, true);
    float xr = 0.f, xi = 0.f;
    if (latent) {
        float pr = k.are, pi = k.aim;
#pragma unroll
        for (int s = 0; s < 8; ++s) { const float t = pr * pr - pi * pi; pi = 2.f * pr * pi; pr = t; asm volatile("" : "+v"(pr), "+v"(pi)); }
        const size_t hidx = ((((size_t)lb * 2 + j) * 2 + dir) * 32 + g) * 64 + lane;
        xr = a.in(I_S5RE)[hidx]; xi = a.in(I_S5IM)[hidx];
        typedef float f32x2 __attribute__((ext_vector_type(2)));
        f32x2 lv[7];
#pragma unroll
        for (int q = 0; q < 7; ++q) { const int c2 = dir ? 7 - q : q; lv[q] = *(const f32x2*)(LOC + ((((size_t)(lb * 8 + c2) * 32 + g) * 2 + dir) * 64 + lane) * 2); }
        const int npre = dir ? 7 - lc : lc;
#pragma unroll
        for (int q = 0; q < 7; ++q) if (q < npre) { const float t = pr * xr - pi * xi + lv[q].x; xi = pr * xi + pi * xr + lv[q].y; xr = t; }
    }
    s5_scan256<true>(k, dir, g, r0, xr, xi, wl, PROJ, Y, lane);
    if (!latent) { const size_t oidx = ((((size_t)sc * 2 + j) * 2 + dir) * 32 + g) * 64 + lane; a.out()[O_S5RE + oidx] = xr; a.out()[O_S5IM + oidx] = xi; }
}
DI void s5a_dir(const Ctx& a, int j, int sc, int g, int dir, LAS unsigned char* wl, int lane) {
    unsigned char* ws = a.ws(); const bf16_t* PROJ = (const bf16_t*)(ws + WS_A); float* Y = (float*)(ws + WS_A + (dir ? A_YB : A_YF)); float* LOC = (float*)(ws + WS_LOC);
    S5C k; s5_consts(a, j, dir, g, lane, k, true);
    float xr = 0.f, xi = 0.f;
    s5_scan256<true>(k, dir, g, sc * 256, xr, xi, wl, PROJ, Y, lane);
    { const size_t oidx = ((((size_t)sc * 2 + j) * 2 + dir) * 32 + g) * 64 + lane; a.out()[O_S5RE + oidx] = xr; a.out()[O_S5IM + oidx] = xi; }
    xr = 0.f; xi = 0.f;
    s5_scan256<false>(k, dir, g, (32 + sc) * 256, xr, xi, wl, PROJ, nullptr, lane);
    float* lp = LOC + ((((size_t)sc * 32 + g) * 2 + dir) * 64 + lane) * 2; lp[0] = xr; lp[1] = xi;
}
DI void s5_combine(const Ctx& a, int j, int sc, int g, int half, int lane) {
    unsigned char* ws = a.ws(); const bf16_t* PROJ = (const bf16_t*)(ws + WS_A); const float* YF = (const float*)(ws + WS_A + A_YF); const float* YB = (const float*)(ws + WS_A + A_YB); bf16_t* Z = (bf16_t*)(ws + WS_A + A_Z);
    const int ch = g * 16 + (lane & 3) * 4; const f32x4 dv = *(const f32x4*)(a.in(I_S5D) + j * 512 + ch);
    f32x4 yfv[8], ybv[8]; u32x2 uwv[8];
#pragma unroll
    for (int it = 0; it < 8; ++it) { const int row = sc * 256 + half * 128 + it * 16 + (lane >> 2);
        yfv[it] = *(const f32x4*)(YF + (size_t)row * 512 + ch); ybv[it] = *(const f32x4*)(YB + (size_t)row * 512 + ch); uwv[it] = *(const u32x2*)(PROJ + (size_t)row * HY_IN + ch); }
#pragma unroll
    for (int it = 0; it < 8; ++it) { const int row = sc * 256 + half * 128 + it * 16 + (lane >> 2);
        const f32x4 yf = yfv[it], yb = ybv[it]; const u32x2 uw = uwv[it];
        const float z0 = gelu_tanh(yf.x + yb.x + dv.x * bflo(uw.x)), z1 = gelu_tanh(yf.y + yb.y + dv.y * bfhi(uw.x)), z2 = gelu_tanh(yf.z + yb.z + dv.z * bflo(uw.y)), z3 = gelu_tanh(yf.w + yb.w + dv.w * bfhi(uw.y));
        u32x2 w; w.x = cvt_pk_bf16(z0, z1); w.y = cvt_pk_bf16(z2, z3); *(u32x2*)(Z + (size_t)row * 512 + ch) = w; }
}
DI void s5_local_unit(const Ctx& a, int j, int lcg, int g, int dir, LAS unsigned char* wl, int lane) {
    unsigned char* ws = a.ws(); const bf16_t* PROJ = (const bf16_t*)(ws + WS_A); float* LOC = (float*)(ws + WS_LOC);
    S5C k; s5_consts(a, j, dir, g, lane, k, false);
    float xr = 0.f, xi = 0.f;
    s5_scan256<false>(k, dir, g, (32 + lcg) * 256, xr, xi, wl, PROJ, nullptr, lane);
    float* lp = LOC + ((((size_t)lcg * 32 + g) * 2 + dir) * 64 + lane) * 2; lp[0] = xr; lp[1] = xi;
}
template <bool CTX_AND_LOCAL>
DI void s5_phase_full(const Ctx& a, int j, int first, LAS unsigned char* wl, int gw, int NGW, int lane) {
    const int ntrip = (2048 + NGW - 1) / NGW;
    for (int tr = 0; tr < ntrip; ++tr) { const int wu = gw + tr * NGW; const bool on = wu < 2048; const int u = wu >> 1, dir = wu & 1;
        if (on) { if (CTX_AND_LOCAL) s5a_dir(a, j, u >> 5, u & 31, dir, wl, lane); else s5_full_dir(a, j, first + (u >> 5), u & 31, dir, wl, lane); }
        asm volatile("s_waitcnt vmcnt(0)" ::: "memory"); __syncthreads();
        if (on) s5_combine(a, j, first + (u >> 5), u & 31, dir, lane);
    }
}
DI void conv_part(const Ctx& a, int j, int gtid, int gthreads) {
    unsigned char* ws = a.ws(); const bf16_t* PROJ = (const bf16_t*)(ws + WS_A); bf16_t* MIX = (bf16_t*)(ws + WS_A + A_MIX);
    const float* cw = a.in(I_CONVW) + j * 3 * 512; const float* cb = a.in(I_CONVB) + j * 512;
    const float* cwp = cw; (void)cwp;
    for (int it = gtid; it < NTOK * 64; it += gthreads) {
        const int r = it >> 6, w0 = (it & 63) * 8;
        const int t = r < NCTX ? (r & 255) : ((r - NCTX) & 2047); const int L = r < NCTX ? 256 : 2048;
        float cvm[8], cv0[8], cvp[8];
        auto ldcv = [&](int rr, float (&o)[8], bool valid) {
            if (!valid) { for (int e = 0; e < 8; ++e) o[e] = 0.f; return; }
            const u32x4 cg4 = *(const u32x4*)(PROJ + (size_t)rr * HY_IN + 1024 + w0), v4 = *(const u32x4*)(PROJ + (size_t)rr * HY_IN + 1536 + w0);
            o[0] = bflo(cg4.x) * bflo(v4.x); o[1] = bfhi(cg4.x) * bfhi(v4.x); o[2] = bflo(cg4.y) * bflo(v4.y); o[3] = bfhi(cg4.y) * bfhi(v4.y);
            o[4] = bflo(cg4.z) * bflo(v4.z); o[5] = bfhi(cg4.z) * bfhi(v4.z); o[6] = bflo(cg4.w) * bflo(v4.w); o[7] = bfhi(cg4.w) * bfhi(v4.w); };
        ldcv(r - 1, cvm, t > 0); ldcv(r, cv0, true); ldcv(r + 1, cvp, t < L - 1);
        const u32x4 bg4 = *(const u32x4*)(PROJ + (size_t)r * HY_IN + 512 + w0);
        const float bg[8] = {bflo(bg4.x), bfhi(bg4.x), bflo(bg4.y), bfhi(bg4.y), bflo(bg4.z), bfhi(bg4.z), bflo(bg4.w), bfhi(bg4.w)};
        float o[8];
#pragma unroll
        for (int e = 0; e < 8; ++e) o[e] = bg[e] * (cw[w0 + e] * cvm[e] + cw[512 + w0 + e] * cv0[e] + cw[1024 + w0 + e] * cvp[e] + cb[w0 + e]);
        u32x4 w; w.x = pk2(o[0], o[1]); w.y = pk2(o[2], o[3]); w.z = pk2(o[4], o[5]); w.w = pk2(o[6], o[7]);
        *(u32x4*)(MIX + (size_t)r * D + 512 + w0) = w;
    }
}

constexpr int VT_PITCH = 144, KS_PITCH = 272;
DI int unperm_dk(int dkp) { return (dkp & 64) + ((dkp & 63) >> 1) + 32 * (dkp & 1); }
DI void vt_load(u32x4 (&r)[4], const bf16_t* src, int wave, int lane) {
    const int kp = lane & 31;
#pragma unroll
    for (int it = 0; it < 2; ++it) { const int dg8 = it * 16 + wave * 2 + (lane >> 5);
        r[2 * it] = *(const u32x4*)(src + (size_t)(2 * kp) * QKV_LD + dg8 * 8); r[2 * it + 1] = *(const u32x4*)(src + (size_t)(2 * kp + 1) * QKV_LD + dg8 * 8); }
}
DI void vt_store(LAS unsigned char* VT, const u32x4 (&r)[4], int wave, int lane) {
    const int kp = lane & 31;
#pragma unroll
    for (int it = 0; it < 2; ++it) { const int dg8 = it * 16 + wave * 2 + (lane >> 5);
        LAS unsigned char* dst = VT + (dg8 * 8) * VT_PITCH + kp * 4;
        const unsigned x0[4] = {r[2 * it].x, r[2 * it].y, r[2 * it].z, r[2 * it].w}, x1[4] = {r[2 * it + 1].x, r[2 * it + 1].y, r[2 * it + 1].z, r[2 * it + 1].w};
#pragma unroll
        for (int e = 0; e < 4; ++e) { *(LAS unsigned*)(dst + (2 * e) * VT_PITCH) = (x0[e] & 0xffffu) | (x1[e] << 16); *(LAS unsigned*)(dst + (2 * e + 1) * VT_PITCH) = (x0[e] >> 16) | (x1[e] & 0xffff0000u); } }
}
DI float log2_sigmoid(float x) { return -log2f(1.f + exp2f(-x * 1.4426950408889634f)); }
DI void ret_state_unit(const Ctx& a, int j, int sc, int hd, LAS unsigned char* lds, int wave, int lane) {
    asm volatile("" : "+v"(lane));
    unsigned char* ws = a.ws(); const bf16_t* PROJ = (const bf16_t*)(ws + WS_A);
    const int l32 = lane & 31, h = lane >> 5, r0 = sc * 256;
    const float lgf = log2_sigmoid(a.in(I_GAMMA)[(j * 2 + 0) * 8 + hd]), lgb = log2_sigmoid(a.in(I_GAMMA)[(j * 2 + 1) * 8 + hd]);
    LAS unsigned char* VT = lds; LAS unsigned char* KTf = lds + 36864; LAS unsigned char* KTb = lds + 36864 + 18432;
    f32x16 acc[2][4];
#pragma unroll
    for (int d = 0; d < 2; ++d)
#pragma unroll
        for (int n = 0; n < 4; ++n) for (int i = 0; i < 16; ++i) acc[d][n][i] = 0.f;
    const int kp = lane & 31, dg8k = wave * 2 + (lane >> 5);
    const bf16_t* blk = PROJ + (size_t)(sc * 8 + hd) * 256 * QKV_LD;
    const bf16_t* vsrc = blk + 256; const bf16_t* ksrc = blk + 128 + dg8k * 8;
    u32x4 vr[4], k0r, k1r;
    vt_load(vr, vsrc, wave, lane); k0r = *(const u32x4*)(ksrc + (size_t)(2 * kp) * QKV_LD); k1r = *(const u32x4*)(ksrc + (size_t)(2 * kp + 1) * QKV_LD);
    for (int jb = 0; jb < 4; ++jb) {
        __syncthreads();
        vt_store(VT, vr, wave, lane);
        { const int key = jb * 64 + 2 * kp;
            const float sf0 = __builtin_amdgcn_exp2f(lgf * (float)(255 - key)), sf1 = __builtin_amdgcn_exp2f(lgf * (float)(254 - key)), sb0 = __builtin_amdgcn_exp2f(lgb * (float)key), sb1 = __builtin_amdgcn_exp2f(lgb * (float)(key + 1));
            const unsigned x0[4] = {k0r.x, k0r.y, k0r.z, k0r.w}, x1[4] = {k1r.x, k1r.y, k1r.z, k1r.w};
#pragma unroll
            for (int e = 0; e < 4; ++e) {
                const float k0l = bflo(x0[e]), k0h = bfhi(x0[e]), k1l = bflo(x1[e]), k1h = bfhi(x1[e]);
                const int off = (dg8k * 8 + 2 * e) * VT_PITCH + kp * 4;
                *(LAS unsigned*)(KTf + off) = cvt_pk_bf16(k0l * sf0, k1l * sf1); *(LAS unsigned*)(KTf + off + VT_PITCH) = cvt_pk_bf16(k0h * sf0, k1h * sf1);
                *(LAS unsigned*)(KTb + off) = cvt_pk_bf16(k0l * sb0, k1l * sb1); *(LAS unsigned*)(KTb + off + VT_PITCH) = cvt_pk_bf16(k0h * sb0, k1h * sb1); } }
        __syncthreads();
        if (jb < 3) { vt_load(vr, vsrc + (size_t)(jb + 1) * 64 * QKV_LD, wave, lane);
            k0r = *(const u32x4*)(ksrc + (size_t)((jb + 1) * 64 + 2 * kp) * QKV_LD); k1r = *(const u32x4*)(ksrc + (size_t)((jb + 1) * 64 + 2 * kp + 1) * QKV_LD); }
        bf16x8 fa[2], fb[2][4], fc[2][4];
#define LDST(buf, ks_) do { fa[buf] = *(const LAS bf16x8*)(VT + (32 * wave + l32) * VT_PITCH + ((ks_) * 16 + 8 * h) * 2); _Pragma("unroll") for (int n = 0; n < 4; ++n) { \
            fb[buf][n] = *(const LAS bf16x8*)(KTf + (n * 32 + l32) * VT_PITCH + ((ks_) * 16 + 8 * h) * 2); fc[buf][n] = *(const LAS bf16x8*)(KTb + (n * 32 + l32) * VT_PITCH + ((ks_) * 16 + 8 * h) * 2); } } while (0)
        LDST(0, 0);
#pragma unroll
        for (int ks = 0; ks < 4; ++ks) {
            if (ks < 3) { if (ks & 1) LDST(0, ks + 1); else LDST(1, ks + 1); }
            __builtin_amdgcn_sched_barrier(0);
#pragma unroll
            for (int n = 0; n < 4; ++n) { acc[0][n] = MFMA32(fa[ks & 1], fb[ks & 1][n], acc[0][n]); acc[1][n] = MFMA32(fa[ks & 1], fc[ks & 1][n], acc[1][n]); }
            __builtin_amdgcn_sched_barrier(0); }
#undef LDST
    }
    if (sc < 32) {
#pragma unroll
        for (int d = 0; d < 2; ++d) { float* op = a.out() + O_RET + ((((size_t)sc * 2 + j) * 2 + d) * 8 + hd) * (size_t)(128 * 256);
#pragma unroll
            for (int n = 0; n < 4; ++n) { const int dk = unperm_dk(n * 32 + l32);
#pragma unroll
                for (int g4 = 0; g4 < 4; ++g4) *(f32x4*)(op + (size_t)dk * 256 + 32 * wave + 8 * g4 + 4 * h) = (f32x4){acc[d][n][4 * g4], acc[d][n][4 * g4 + 1], acc[d][n][4 * g4 + 2], acc[d][n][4 * g4 + 3]}; } }
    } else {
        const int lb = (sc - 32) >> 3, lc = (sc - 32) & 7; bf16_t* LOCAL = (bf16_t*)(ws + WS_LOCAL);
#pragma unroll
        for (int d = 0; d < 2; ++d) { bf16_t* op = LOCAL + ((((size_t)lb * 8 + hd) * 8 + lc) * 2 + d) * (size_t)(256 * 128);
#pragma unroll
            for (int n = 0; n < 4; ++n)
#pragma unroll
                for (int r = 0; r < 16; ++r) op[(size_t)(32 * wave + crow(r, h)) * 128 + n * 32 + l32] = (bf16_t)f2bf(acc[d][n][r]); }
    }
}
DI void ret_prefix(const Ctx& a, int j, int gtid, int gthreads) {
    unsigned char* ws = a.ws(); const bf16_t* LOCAL = (const bf16_t*)(ws + WS_LOCAL); bf16_t* SIN = (bf16_t*)(ws + WS_XN);
    for (int it = gtid; it < 4 * 8 * 2 * 4096; it += gthreads) {
        const int e8 = it & 4095, d = (it >> 12) & 1, hd = (it >> 13) & 7, lb = it >> 16;
        const int dv = e8 >> 4, dk0 = (e8 & 15) * 8;
        const float lg = log2_sigmoid(a.in(I_GAMMA)[(j * 2 + d) * 8 + hd]);
        const float cd = exp2f(lg * 256.f);
        const float* s0 = a.in(I_SRET) + ((((size_t)lb * 2 + j) * 2 + d) * 8 + hd) * (size_t)(128 * 256);
        float s[8];
#pragma unroll
        for (int e = 0; e < 8; ++e) s[e] = s0[(size_t)unperm_dk(dk0 + e) * 256 + dv];
        u32x4 lv[8];
#pragma unroll
        for (int cc = 0; cc < 8; ++cc) { const int c = d ? 7 - cc : cc; lv[cc] = *(const u32x4*)(LOCAL + ((((size_t)lb * 8 + hd) * 8 + c) * 2 + d) * (size_t)(256 * 128) + (size_t)dv * 128 + dk0); }
#pragma unroll
        for (int cc = 0; cc < 8; ++cc) { const int c = d ? 7 - cc : cc;
            const size_t blk = ((((size_t)lb * 8 + hd) * 8 + c) * 2 + d) * (size_t)(256 * 128) + (size_t)dv * 128 + dk0;
            u32x4 w; w.x = pk2(s[0], s[1]); w.y = pk2(s[2], s[3]); w.z = pk2(s[4], s[5]); w.w = pk2(s[6], s[7]);
            *(u32x4*)(SIN + blk) = w;
            const u32x4 l4 = lv[cc];
            s[0] = cd * s[0] + bflo(l4.x); s[1] = cd * s[1] + bfhi(l4.x); s[2] = cd * s[2] + bflo(l4.y); s[3] = cd * s[3] + bfhi(l4.y);
            s[4] = cd * s[4] + bflo(l4.z); s[5] = cd * s[5] + bfhi(l4.z); s[6] = cd * s[6] + bflo(l4.w); s[7] = cd * s[7] + bfhi(l4.w); }
    }
}
DI void ret_out_unit(const Ctx& a, int j, int sc, int hd, LAS unsigned char* lds, int wave, int lane, bf16_t* dup_dst = nullptr) {
    asm volatile("v_mbcnt_lo_u32_b32 %0, -1, 0\n\tv_mbcnt_hi_u32_b32 %0, -1, %0" : "=v"(lane));
    unsigned char* ws = a.ws(); bf16_t* PROJ = (bf16_t*)(ws + WS_A);
    const int l32 = lane & 31, h = lane >> 5, r0 = sc * 256, tid = wave * 64 + lane;
    const float lgf = log2_sigmoid(a.in(I_GAMMA)[(j * 2 + 0) * 8 + hd]), lgb = log2_sigmoid(a.in(I_GAMMA)[(j * 2 + 1) * 8 + hd]);
    LAS unsigned char* VT = lds; LAS unsigned char* KS = lds + 36864;
    const int qi = 32 * wave + l32;
    LAS unsigned char* QS = lds + 36864 + 17408;
    const bf16_t* blk = PROJ + (size_t)(sc * 8 + hd) * 256 * QKV_LD;
    u32x4 sr[4][4];
    if (sc >= 32) { const int lb_ = (sc - 32) >> 3, lc_ = (sc - 32) & 7; const bf16_t* sf_ = (const bf16_t*)(ws + WS_XN) + ((((size_t)lb_ * 8 + hd) * 8 + lc_) * 2 + 0) * (size_t)(256 * 128);
#pragma unroll
        for (int rd = 0; rd < 4; ++rd) { const bf16_t* sp_ = sf_ + (size_t)(rd & 1) * 256 * 128 + (size_t)(rd >> 1) * 128 * 128;
#pragma unroll
            for (int it = 0; it < 4; ++it) { const int id = tid + it * 512; sr[rd][it] = *(const u32x4*)(sp_ + (size_t)(id >> 4) * 128 + (id & 15) * 8); } } }
    __syncthreads();
#pragma unroll
    for (int it = 0; it < 8; ++it) { const int id = tid + it * 512, row = id >> 4, part = id & 15;
        *(LAS u32x4*)(QS + row * KS_PITCH + part * 16) = *(const u32x4*)(blk + (size_t)row * QKV_LD + part * 8); }
    __syncthreads();
    const LAS unsigned char* qrow = QS + qi * KS_PITCH + 16 * h;
#define QF(ks) (*(const LAS bf16x8*)(qrow + (ks) * 32))
    f32x16 acc[8];
#pragma unroll
    for (int t = 0; t < 8; ++t) for (int i = 0; i < 16; ++i) acc[t][i] = 0.f;
    if (sc >= 32) {
        const int lb = (sc - 32) >> 3, lc = (sc - 32) & 7; const bf16_t* SIN = (const bf16_t*)(ws + WS_XN);
        const bf16_t* sf = SIN + ((((size_t)lb * 8 + hd) * 8 + lc) * 2 + 0) * (size_t)(256 * 128); const bf16_t* sb = sf + 256 * 128;
        const float wf_ = __builtin_amdgcn_exp2f(lgf * (float)(qi + 1)), wb_ = __builtin_amdgcn_exp2f(lgb * (float)(256 - qi)); const float ratio = __builtin_amdgcn_exp2f(lgf * (float)(qi + 1) - lgb * (float)(256 - qi));
        bf16x8 qq[8];
#pragma unroll
        for (int ks = 0; ks < 8; ++ks) qq[ks] = QF(ks);
        LAS unsigned char* SS = lds;
#pragma unroll
        for (int rd = 0; rd < 4; ++rd) {
            __syncthreads();
#pragma unroll
            for (int it = 0; it < 4; ++it) { const int id = tid + it * 512; *(LAS u32x4*)(SS + (id >> 4) * KS_PITCH + (id & 15) * 16) = sr[rd][it]; }
            __syncthreads();
#pragma unroll
            for (int tt = 0; tt < 4; ++tt) { const int t = (rd >> 1) * 4 + tt;
                bf16x8 af[8];
#pragma unroll
                for (int ks = 0; ks < 8; ++ks) af[ks] = *(const LAS bf16x8*)(SS + (tt * 32 + l32) * KS_PITCH + (ks * 16 + 8 * h) * 2);
                __builtin_amdgcn_sched_barrier(0);
#pragma unroll
                for (int ks = 0; ks < 8; ++ks) acc[t] = MFMA32(af[ks], qq[ks], acc[t]);
                acc[t] = acc[t] * ((rd & 1) ? wb_ : ratio);
                __builtin_amdgcn_sched_barrier(0); }
        }
    }
    const bf16_t* vsrc = blk + 256; const bf16_t* ksrc = blk + (size_t)(tid >> 4) * QKV_LD + 128 + (tid & 15) * 8;
    u32x4 vr[4], kr0, kr1;
    vt_load(vr, vsrc, wave, lane); kr0 = *(const u32x4*)ksrc; kr1 = *(const u32x4*)(ksrc + (size_t)32 * QKV_LD);
    for (int jb = 0; jb < 4; ++jb) {
        __syncthreads();
        vt_store(VT, vr, wave, lane);
        *(LAS u32x4*)(KS + (tid >> 4) * KS_PITCH + (tid & 15) * 16) = kr0; *(LAS u32x4*)(KS + (32 + (tid >> 4)) * KS_PITCH + (tid & 15) * 16) = kr1;
        __syncthreads();
        if (jb < 3) { vt_load(vr, vsrc + (size_t)(jb + 1) * 64 * QKV_LD, wave, lane); kr0 = *(const u32x4*)(ksrc + (size_t)(jb + 1) * 64 * QKV_LD); kr1 = *(const u32x4*)(ksrc + (size_t)((jb + 1) * 64 + 32) * QKV_LD); }
#pragma unroll
        for (int mt = 0; mt < 2; ++mt) {
            f32x16 st; for (int i = 0; i < 16; ++i) st[i] = 0.f;
#pragma unroll
            for (int hf = 0; hf < 2; ++hf) { bf16x8 kf[4], qq[4];
#pragma unroll
                for (int i = 0; i < 4; ++i) { const int ks = hf * 4 + i; kf[i] = *(const LAS bf16x8*)(KS + (mt * 32 + l32) * KS_PITCH + (ks * 16 + 8 * h) * 2); qq[i] = QF(ks); }
                __builtin_amdgcn_sched_barrier(0);
#pragma unroll
                for (int i = 0; i < 4; ++i) st = MFMA32(kf[i], qq[i], st);
                __builtin_amdgcn_sched_barrier(0); }
            bf16x8 vf[8];
#define LDVF(s_, t0_) do { _Pragma("unroll") for (int t = (t0_); t < (t0_) + 4; ++t) { const LAS unsigned char* vp = VT + (t * 32 + l32) * VT_PITCH + (mt * 32 + 16 * (s_) + 4 * h) * 2; \
                const s16x4 lo = *(const LAS s16x4*)vp, hi = *(const LAS s16x4*)(vp + 16); vf[t] = __builtin_shufflevector(lo, hi, 0, 1, 2, 3, 4, 5, 6, 7); } } while (0)
            LDVF(0, 0); LDVF(0, 4);
            __builtin_amdgcn_sched_barrier(0);
#pragma unroll
            for (int r = 0; r < 16; ++r) { const int kj = jb * 64 + mt * 32 + crow(r, h); const int df = qi - kj;
                const float dcy = df == 0 ? 2.f : __builtin_amdgcn_exp2f((df > 0 ? lgf : -lgb) * (float)df); st[r] *= dcy; }
#pragma unroll
            for (int s = 0; s < 2; ++s) {
                u32x4 pw;
                asm volatile("v_cvt_pk_bf16_f32 %0, %4, %5\n\tv_cvt_pk_bf16_f32 %1, %6, %7\n\tv_cvt_pk_bf16_f32 %2, %8, %9\n\tv_cvt_pk_bf16_f32 %3, %10, %11\n\ts_nop 1"
                             : "=&v"(pw[0]), "=&v"(pw[1]), "=&v"(pw[2]), "=&v"(pw[3])
                             : "v"(st[8 * s]), "v"(st[8 * s + 1]), "v"(st[8 * s + 2]), "v"(st[8 * s + 3]), "v"(st[8 * s + 4]), "v"(st[8 * s + 5]), "v"(st[8 * s + 6]), "v"(st[8 * s + 7]));
                const bf16x8 pf = __builtin_bit_cast(bf16x8, pw);
                __builtin_amdgcn_sched_barrier(0);
#pragma unroll
                for (int t = 0; t < 4; ++t) acc[t] = MFMA32(vf[t], pf, acc[t]);
                __builtin_amdgcn_sched_barrier(0);
                if (s == 0) { LDVF(1, 0); __builtin_amdgcn_sched_barrier(0); }
#pragma unroll
                for (int t = 4; t < 8; ++t) acc[t] = MFMA32(vf[t], pf, acc[t]);
                __builtin_amdgcn_sched_barrier(0);
                if (s == 0) { LDVF(1, 4); __builtin_amdgcn_sched_barrier(0); }
            }
#undef LDVF
        }
    }
    float ss = 0.f;
#pragma unroll
    for (int t = 0; t < 8; ++t) for (int i = 0; i < 16; ++i) ss += acc[t][i] * acc[t][i];
    ss += shfl_xor_l(ss, 32, lane);
    const float rstd = 1.f / sqrtf(ss * (1.f / 256.f) + EPS);
    bf16_t* grow = PROJ + A_OG / 2 + (size_t)(r0 + qi) * 2048 + hd * 256; const float* gn = a.in(I_GNW) + j * 2048 + hd * 256;
#pragma unroll
    for (int tb = 0; tb < 8; tb += 2) {
        u32x2 gwv[8]; f32x4 gnv[8];
#pragma unroll
        for (int q = 0; q < 8; ++q) { const int dv0 = 32 * (tb + (q >> 2)) + 8 * (q & 3) + 4 * h; gwv[q] = *(const u32x2*)(grow + dv0); gnv[q] = *(const f32x4*)(gn + dv0); }
#pragma unroll
        for (int q = 0; q < 8; ++q) { const int t = tb + (q >> 2), g4 = q & 3, dv0 = 32 * t + 8 * g4 + 4 * h;
            const float o0 = siluf_(bflo(gwv[q].x)) * acc[t][4 * g4] * rstd * gnv[q].x, o1 = siluf_(bfhi(gwv[q].x)) * acc[t][4 * g4 + 1] * rstd * gnv[q].y,
                        o2 = siluf_(bflo(gwv[q].y)) * acc[t][4 * g4 + 2] * rstd * gnv[q].z, o3 = siluf_(bfhi(gwv[q].y)) * acc[t][4 * g4 + 3] * rstd * gnv[q].w;
            u32x2 w; w.x = cvt_pk_bf16(o0, o1); w.y = cvt_pk_bf16(o2, o3); *(u32x2*)(grow + dv0) = w; }
    }
#undef QF
}


#define XB_TMO      128
#define XB_XCNT(j)  (256  + 64 * (j))
#define XB_XSUB(j)  (1280 + 64 * (j))
#define XB_XGEN(j)  (2304 + 64 * (j))
#define XB_TOP      3328
#define XB_TOPGEN   3392
#define XCD_BAR_WORDS 3456
#define XB_SPIN_CAP (1u << 18)
DI unsigned xb_ld(unsigned* p)              { return __hip_atomic_load(p, __ATOMIC_RELAXED, __HIP_MEMORY_SCOPE_AGENT); }
DI unsigned xb_add(unsigned* p, unsigned v) { return __hip_atomic_fetch_add(p, v, __ATOMIC_RELAXED, __HIP_MEMORY_SCOPE_AGENT); }
DI unsigned xb_xcc_id() { return (unsigned)__builtin_amdgcn_s_getreg((3 << 11) | 20) & 0xFu; }
#define XB_SPIN(cond, bar) do { unsigned _sp = 0; while (cond) { __builtin_amdgcn_s_sleep(1); \
    if ((++_sp & 255u) == 0u) { if (xb_ld(&(bar)[XB_TMO])) break; if (_sp > XB_SPIN_CAP) { atomicAdd(&(bar)[XB_TMO], 1u); break; } } } } while (0)
struct XcdBarrier { unsigned* bar; unsigned x; volatile LAS unsigned* st; };
DI void xcd_barrier_complete(unsigned* bar, unsigned x, unsigned& nloc, unsigned& nx) {
    const unsigned G = gridDim.x * gridDim.y * gridDim.z;
    unsigned sum, cnt, mine, sp = 0u;
    for (;;) {
        sum = 0u; cnt = 0u; mine = 0u;
#pragma unroll
        for (unsigned j = 0; j < 16; ++j) { const unsigned c = xb_ld(&bar[XB_XCNT(j)]); sum += c; cnt += (c > 0u) ? 1u : 0u; mine = (j == x) ? c : mine; }
        if (sum == G) break;
        __builtin_amdgcn_s_sleep(1);
        if ((++sp & 255u) == 0u) { if (xb_ld(&bar[XB_TMO])) break; if (sp > XB_SPIN_CAP) { atomicAdd(&bar[XB_TMO], 1u); break; } }
    }
    nloc = mine > 0u ? mine : 1u; nx = cnt > 0u ? cnt : 1u;
}
DI void xcd_barrier(const XcdBarrier& b) {
    asm volatile("s_waitcnt vmcnt(0)" ::: "memory");
    __syncthreads();
    if (threadIdx.x == 0) {
        unsigned* bar = b.bar;
        __builtin_amdgcn_s_waitcnt(0);
        unsigned nloc = b.st[0], nx = b.st[1];
        if (nloc == 0u) { xcd_barrier_complete(bar, b.x, nloc, nx); b.st[0] = nloc; b.st[1] = nx; }
        const unsigned old = xb_add(&bar[XB_XSUB(b.x)], 1u);
        const unsigned gen = old / nloc;
        if (old + 1u == (gen + 1u) * nloc) {
            __builtin_amdgcn_fence(__ATOMIC_RELEASE, "agent");
            asm volatile("s_waitcnt vmcnt(0)" ::: "memory");
            const unsigned og = xb_add(&bar[XB_TOP], 1u);
            const unsigned tg = og / nx;
            if (og + 1u == (tg + 1u) * nx) xb_add(&bar[XB_TOPGEN], 1u);
            else XB_SPIN(xb_ld(&bar[XB_TOPGEN]) == tg, bar);
            __builtin_amdgcn_fence(__ATOMIC_ACQUIRE, "agent");
            xb_add(&bar[XB_XGEN(b.x)], 1u);
            asm volatile("s_waitcnt vmcnt(0)" ::: "memory");
        } else {
            XB_SPIN(xb_ld(&bar[XB_XGEN(b.x)]) == gen, bar);
            __builtin_amdgcn_fence(__ATOMIC_ACQUIRE, "agent");
            asm volatile("s_waitcnt vmcnt(0)" ::: "memory");
        }
    }
    __syncthreads();
}
constexpr size_t WS_BAR = 65536;
constexpr int LDS_ST_OFF = LDS_BYTES - 64;
__global__ void __launch_bounds__(NWAVES * 64, 2) fwd_kernel(Args a0) {
    extern __shared__ __attribute__((aligned(16))) unsigned char lds_raw[];
    LAS unsigned char* lds = (LAS unsigned char*)lds_raw;
    cg::grid_group grid = cg::this_grid();
    const int tid0 = threadIdx.x;
    const int wave0 = __builtin_amdgcn_readfirstlane(tid0 >> 6);
    const int G = gridDim.x, bx = blockIdx.x;
    const int NGW = G * NWAVES, gthreads = G * NWAVES * 64;
#define FRESH() int lane; asm volatile("v_mbcnt_lo_u32_b32 %0, -1, 0\n\tv_mbcnt_hi_u32_b32 %0, -1, %0" : "=v"(lane)); int wave = wave0; asm volatile("" : "+s"(wave)); const int tid = wave * 64 + lane; \
    const int gw = bx * NWAVES + wave, gtid = bx * (NWAVES * 64) + tid; (void)lane; (void)gw; (void)gtid; \
    const Args* ap_ = (const Args*)a0.ws; asm volatile("" : "+s"(ap_)); Ctx a; a.t = ap_; unsigned char* ws = a.ws(); float* X = a.out(); float* MOD = (float*)(ws + WS_MOD); bf16_t* XN = (bf16_t*)(ws + WS_XN); \
    (void)X; (void)MOD; (void)XN
    if (tid0 < 2) ((volatile LAS unsigned*)(lds + LDS_ST_OFF))[tid0] = 0u;
    __syncthreads();
    if (!MK_MULTI && tid0 == 0) (void)xb_add(&((unsigned*)(a0.ws + WS_BAR))[XB_XCNT(xb_xcc_id())], 1u);
    const int lo = a0.lo, hi = a0.hi;
#ifndef PHASE_MASK
#define PHASE_MASK 0xFFFFFFFFu
#endif
#define KON(kind) (((PHASE_MASK) >> (kind)) & 1u)
#ifndef PROBE_DUP
#define PROBE_DUP 0u
#endif
#define REPS(kind) for (int rep_ = 0; rep_ < ((((PROBE_DUP) >> (kind)) & 1u) ? 2 : 1); ++rep_)
#define RUN(k) (lo <= (k) && (k) < hi)
#define SEAM(k) do { if (RUN(k) && RUN((k) + 1)) { XcdBarrier b_; b_.bar = (unsigned*)(a0.ws + WS_BAR); b_.x = xb_xcc_id(); b_.st = (volatile LAS unsigned*)(lds + LDS_ST_OFF); xcd_barrier(b_); \
        if ((k) == 0 && a0.hi < 0) grid.sync(); } } while (0)

    if (KON(0) && RUN(0)) REPS(0) {
        const int tid = tid0, lane = tid & 63, wave = __builtin_amdgcn_readfirstlane(tid >> 6), gw = bx * NWAVES + wave;
        if (bx == 0 && tid == 0) { Args* t = (Args*)a0.ws;
#pragma unroll
            for (int k = 0; k < 32; ++k) t->in[k] = a0.in[k];
            t->out = a0.out; t->ws = a0.ws; t->lo = 0; t->hi = 0; }
        { float* rs = (float*)(a0.ws + WS_ROWSS); for (int e = bx * (NWAVES * 64) + tid; e < 9 * NTOK; e += gthreads) rs[e] = 0.f; }
        p0_prologue(a0, lds, gw, NGW, wave, lane); }
    SEAM(0);
    if (KON(1) && RUN(1)) REPS(1) { FRESH();
        const float* MODP = (const float*)(ws + WS_MODP);
        for (int e = gtid; e < 4 * 5 * 6144; e += gthreads) { const int l = e / 30720, rem = e % 30720, n = rem % 6144;
            float s = a.in(I_ADAB)[l * 6144 + n];
#pragma unroll
            for (int kc = 0; kc < 16; ++kc) s += MODP[(size_t)kc * (4 * 5 * 6144) + e];
            MOD[e] = s; }
    }
    SEAM(1);
    float* ROWSS = (float*)(a0.ws + WS_ROWSS); float* GAIN = (float*)(a0.ws + WS_GAIN); float* SHW = (float*)(a0.ws + WS_SHW);
    if (KON(2) && RUN(2)) REPS(2) { FRESH();
        { const float* xp_ = a.in(I_XP); const float* xs_ = a.in(I_XS); const float* nw_ = a.in(I_N1W);
            auto rowp = [&](int r) { return r < NCTX ? xp_ + (size_t)r * D : xs_ + (size_t)(r - NCTX) * D; };
            f32x4 cur[4], nxt[4], nwv[4];
#pragma unroll
            for (int q = 0; q < 4; ++q) { cur[q] = ((const f32x4*)rowp(gw) + lane)[64 * q]; nwv[q] = *(const f32x4*)(nw_ + 4 * lane + 256 * q); }
            for (int r = gw; r < NTOK; r += NGW) { const int cnd = cond_of_row(r);
                const int rn = (r + NGW < NTOK) ? r + NGW : r;
#pragma unroll
                for (int q = 0; q < 4; ++q) nxt[q] = ((const f32x4*)rowp(rn) + lane)[64 * q];
                float ss = 0.f; unsigned long long* o8 = (unsigned long long*)(XN + (size_t)r * D) + lane;
#pragma unroll
                for (int q = 0; q < 4; ++q) { const f32x4 v = cur[q]; ss += (v.x * v.x + v.y * v.y) + (v.z * v.z + v.w * v.w);
                    const f32x4 o = v * nwv[q] * (*(const f32x4*)(MOD + cnd * 6144 + 1024 + 4 * lane + 256 * q) + 1.f);
                    o8[64 * q] = (unsigned long long)pk2(o.x, o.y) | ((unsigned long long)pk2(o.z, o.w) << 32); }
                ss = wave_sum(ss, lane); if (lane == 0) ROWSS[r] = ss;
#pragma unroll
                for (int q = 0; q < 4; ++q) cur[q] = nxt[q]; } }
        for (int e = gtid; e < 7 * 5 * D; e += gthreads) { const int n = 1 + e / (5 * D), cnd = (e / D) % 5, col = e % D, li = n >> 1;
            const float wv = (n & 1) ? a.in(I_N2W)[li * D + col] : a.in(I_N1W)[li * D + col];
            GAIN[(size_t)(n * 5 + cnd) * D + col] = wv * (1.f + MOD[(size_t)(li * 5 + cnd) * 6144 + ((n & 1) ? 4096 : 1024) + col]); }
        { const int n = gw & 7, li = n >> 1, jj = li >> 1, wsub = gw >> 3, nsub = NGW >> 3;
            const int N = (n & 1) ? FF : ((li & 1) ? RET_IN : HY_IN);
            const bf16_t* Wt = (n & 1) ? (const bf16_t*)(ws + WS_W1) + (size_t)li * D * FF : ((li & 1) ? (const bf16_t*)(ws + WS_RETIN) + (size_t)jj * D * RET_IN : (const bf16_t*)(ws + WS_HYIN) + (size_t)jj * D * HY_IN);
            const float* shb = MOD + (size_t)li * 5 * 6144 + ((n & 1) ? 3072 : 0) + 16 * lane;
            f32x4 sh[5][4];
#pragma unroll
            for (int cnd = 0; cnd < 5; ++cnd)
#pragma unroll
                for (int q = 0; q < 4; ++q) sh[cnd][q] = *(const f32x4*)(shb + cnd * 6144 + 4 * q);
            for (int c0 = wsub; c0 < N; c0 += 8 * nsub) {
                u32x4 wv[8][2];
#pragma unroll
                for (int cc = 0; cc < 8; ++cc) { const int col = c0 + cc * nsub; const int cl = col < N ? col : c0; wv[cc][0] = *(const u32x4*)(Wt + (size_t)cl * D + 16 * lane); wv[cc][1] = *(const u32x4*)(Wt + (size_t)cl * D + 16 * lane + 8); }
#pragma unroll
                for (int cc = 0; cc < 8; ++cc) { const int col = c0 + cc * nsub; if (col >= N) break;
                    const u32x4 w0 = wv[cc][0], w1 = wv[cc][1];
                    const float wf[16] = {bflo(w0.x), bfhi(w0.x), bflo(w0.y), bfhi(w0.y), bflo(w0.z), bfhi(w0.z), bflo(w0.w), bfhi(w0.w), bflo(w1.x), bfhi(w1.x), bflo(w1.y), bfhi(w1.y), bflo(w1.z), bfhi(w1.z), bflo(w1.w), bfhi(w1.w)};
                    float dsum[5];
#pragma unroll
                    for (int cnd = 0; cnd < 5; ++cnd) { float d = 0.f;
#pragma unroll
                        for (int q = 0; q < 4; ++q) d += (sh[cnd][q].x * wf[4 * q] + sh[cnd][q].y * wf[4 * q + 1]) + (sh[cnd][q].z * wf[4 * q + 2] + sh[cnd][q].w * wf[4 * q + 3]);
                        dsum[cnd] = wave_sum(d, lane); }
                    if (lane == 0) {
#pragma unroll
                        for (int cnd = 0; cnd < 5; ++cnd) SHW[(size_t)(n * 5 + cnd) * 6144 + col] = dsum[cnd]; } } } }
    }
    SEAM(2);
    for (int i = 0; i < DEPTH; ++i) {
        const int pb = 3 + 7 * i, j = i >> 1;
#define modl (MOD + (size_t)i * 5 * 6144)
        if ((i & 1) == 0) {
            if (KON(3) && RUN(pb + 0)) REPS(3) { FRESH(); pg8::Gemm g{XN, (const bf16_t*)(ws + WS_HYIN) + (size_t)j * D * HY_IN, NTOK, HY_IN, D, D}; pg8::StaticOrder S; S.init(NTOK, HY_IN, G, bx);
                Epi<0> E{}; E.O = (bf16_t*)(ws + WS_A); E.ldc = HY_IN; E.rowss = ROWSS + (size_t)(2 * i) * NTOK; E.shw = SHW + (size_t)(2 * i) * 5 * 6144; pg8::gemm_phase(lds, g, S, E, tid); }
            SEAM(pb + 0);
            if (KON(4) && RUN(pb + 1)) REPS(4) { FRESH();
                LAS unsigned char* wl = lds + wave * 16896;
                s5_phase_full<true>(a, j, 0, wl, gw, NGW, lane);
                conv_part(a, j, gtid, gthreads);
            }
            SEAM(pb + 1);
            if (KON(5) && RUN(pb + 2)) REPS(5) { FRESH();
                LAS unsigned char* wl = lds + wave * 16896;
                s5_phase_full<false>(a, j, 32, wl, gw, NGW, lane);
            }
            SEAM(pb + 2);
            if (KON(6) && RUN(pb + 3)) REPS(6) { FRESH(); pg8::Gemm g{(const bf16_t*)(ws + WS_A + A_Z), (const bf16_t*)(ws + WS_GLU) + (size_t)j * 512 * 512, NTOK, 512, 512, 512}; pg8::StaticOrder S; S.init(NTOK, 512, G, bx);
                Epi<3> E{}; E.O = (bf16_t*)(ws + WS_A + A_MIX); E.ldc = D; E.bias = a.in(I_GLUB) + j * 512; E.Zp = (const bf16_t*)(ws + WS_A + A_Z); E.ldz = 512; pg8::gemm_phase(lds, g, S, E, tid); }
            SEAM(pb + 3);
            if (KON(7) && RUN(pb + 4)) REPS(7) { FRESH(); pg8::Gemm g{(const bf16_t*)(ws + WS_A + A_MIX), (const bf16_t*)(ws + WS_HYOUT) + (size_t)j * D * D, NTOK, D, D, D}; pg8::StaticOrder S; S.init(NTOK, D, G, bx);
                Epi<4> E{}; E.base0 = (i == 0) ? a.in(I_XP) : X; E.base1 = (i == 0) ? a.in(I_XS) : X + (size_t)NCTX * D; E.out = X; E.gate = modl + 2048;
                E.xn = XN; E.gain = GAIN + (size_t)(2 * i + 1) * 5 * D; E.rowss_out = ROWSS + (size_t)(2 * i + 1) * NTOK; pg8::gemm_phase(lds, g, S, E, tid); }
            SEAM(pb + 4);
        } else {
            if (KON(8) && RUN(pb + 0)) REPS(8) { FRESH(); pg8::Gemm g{XN, (const bf16_t*)(ws + WS_RETIN) + (size_t)j * D * RET_IN, NTOK, RET_IN, D, D}; pg8::StaticOrder S; S.init(NTOK, RET_IN, G, bx);
                Epi<2> E{}; E.O = (bf16_t*)(ws + WS_A); E.ldc = RET_IN; E.rowss = ROWSS + (size_t)(2 * i) * NTOK; E.shw = SHW + (size_t)(2 * i) * 5 * 6144; pg8::gemm_phase(lds, g, S, E, tid); }
            SEAM(pb + 0);
            if (KON(9) && RUN(pb + 1)) REPS(9) { FRESH();
                for (int u = bx; u < 512; u += G) ret_state_unit(a, j, u >> 3, u & 7, lds, wave, lane);
                CFENCE();
                for (int u = bx; u < 256; u += G) ret_out_unit(a, j, u >> 3, u & 7, lds, wave, lane);
            }
            SEAM(pb + 1);
            if (KON(10) && RUN(pb + 2)) REPS(10) { FRESH(); ret_prefix(a, j, gtid, gthreads); }
            SEAM(pb + 2);
            if (KON(11) && RUN(pb + 3)) REPS(11) { FRESH(); for (int u = bx; u < 256; u += G) ret_out_unit(a, j, 32 + (u >> 3), u & 7, lds, wave, lane); }
            SEAM(pb + 3);
            if (KON(12) && RUN(pb + 4)) REPS(12) { FRESH(); pg8::Gemm g{(const bf16_t*)(ws + WS_A + A_OG), (const bf16_t*)(ws + WS_RETOUT) + (size_t)j * 2048 * D, NTOK, D, 2048, 2048}; pg8::StaticOrder S; S.init(NTOK, D, G, bx);
                Epi<4> E{}; E.base0 = X; E.base1 = X + (size_t)NCTX * D; E.out = X; E.gate = modl + 2048;
                E.xn = XN; E.gain = GAIN + (size_t)(2 * i + 1) * 5 * D; E.rowss_out = ROWSS + (size_t)(2 * i + 1) * NTOK; pg8::gemm_phase(lds, g, S, E, tid); }
            SEAM(pb + 4);
        }
        if (KON(13) && RUN(pb + 5)) REPS(13) { FRESH(); pg8::Gemm g{XN, (const bf16_t*)(ws + WS_W1) + (size_t)i * D * FF, NTOK, FF, D, D}; pg8::StaticOrder S; S.init(NTOK, FF, G, bx);
            Epi<1> E{}; E.O = (bf16_t*)(ws + WS_A); E.ldc = FF; E.rowss = ROWSS + (size_t)(2 * i + 1) * NTOK; E.shw = SHW + (size_t)(2 * i + 1) * 5 * 6144; pg8::gemm_phase(lds, g, S, E, tid); }
        SEAM(pb + 5);
        if (KON(14) && RUN(pb + 6)) REPS(14) { FRESH(); pg8::Gemm g{(const bf16_t*)(ws + WS_A), (const bf16_t*)(ws + WS_W2) + (size_t)i * FF * D, NTOK, D, FF, FF}; pg8::StaticOrder S; S.init(NTOK, D, G, bx);
            Epi<4> E{}; E.base0 = X; E.base1 = X + (size_t)NCTX * D; E.out = X; E.gate = modl + 5120;
            E.xn = XN; E.gain = (i < DEPTH - 1) ? GAIN + (size_t)(2 * i + 2) * 5 * D : nullptr; E.rowss_out = ROWSS + (size_t)(2 * i + 2) * NTOK; pg8::gemm_phase(lds, g, S, E, tid); }
        SEAM(pb + 6);
    }
    if (KON(15) && RUN(31)) REPS(15) { FRESH();
        const float* fw = a.in(I_FNW);
        f32x4 fwv[4], v[4], nxt[4];
#pragma unroll
        for (int q = 0; q < 4; ++q) { fwv[q] = *(const f32x4*)(fw + 4 * lane + 256 * q); v[q] = ((const f32x4*)(X + (size_t)gw * D) + lane)[64 * q]; }
        for (int r = gw; r < NTOK; r += NGW) {
            f32x4* xr = (f32x4*)(X + (size_t)r * D) + lane;
            const int rn = (r + NGW < NTOK) ? r + NGW : r;
#pragma unroll
            for (int q = 0; q < 4; ++q) nxt[q] = ((const f32x4*)(X + (size_t)rn * D) + lane)[64 * q];
            const float rstd = 1.f / sqrtf(ROWSS[(size_t)8 * NTOK + r] * (1.f / D) + EPS);
#pragma unroll
            for (int q = 0; q < 4; ++q) xr[64 * q] = v[q] * rstd * fwv[q];
#pragma unroll
            for (int q = 0; q < 4; ++q) v[q] = nxt[q];
        }
    }
#undef RUN
#undef modl
#undef FRESH
#undef KON
#undef SEAM
}
constexpr int N_PHASES = 32;

extern "C" void kernel_launch(void* const* d_in, const int* in_sizes, int n_in, void* d_out, int out_size, void* d_ws, size_t ws_size, hipStream_t stream) {
    static int grid = 0;
    if (grid == 0) {
        if (n_in != 32 || ws_size < WS_END) { fprintf(stderr, "kernel_launch: unexpected n_in %d / ws_size %zu\n", n_in, ws_size); grid = -1; return; }
        int dev = 0, cus = 0, per_cu = 0;
        (void)hipGetDevice(&dev); (void)hipDeviceGetAttribute(&cus, hipDeviceAttributeMultiprocessorCount, dev);
        if (hipFuncSetAttribute((const void*)fwd_kernel, hipFuncAttributeMaxDynamicSharedMemorySize, LDS_BYTES) != hipSuccess) { fprintf(stderr, "kernel_launch: hipFuncSetAttribute failed\n"); grid = -1; return; }
        (void)hipOccupancyMaxActiveBlocksPerMultiprocessor(&per_cu, (const void*)fwd_kernel, NWAVES * 64, LDS_BYTES);
        (void)hipGetLastError();
        if (per_cu < 1) fprintf(stderr, "kernel_launch: occupancy query says %d\n", per_cu);
        grid = cus > 0 ? cus : 256;
    }
    if (grid < 0) return;
    Args a{};
    for (int i = 0; i < 32; ++i) a.in[i] = (const float*)d_in[i];
    a.out = (float*)d_out; a.ws = (unsigned char*)d_ws;
#if MK_MULTI
    for (int p = 0; p < N_PHASES; ++p) { a.lo = p; a.hi = p + 1; hipLaunchKernelGGL(fwd_kernel, dim3(grid), dim3(NWAVES * 64), LDS_BYTES, stream, a); }
#else
    a.lo = 0; a.hi = N_PHASES;
    if (hipMemsetAsync((char*)d_ws + WS_BAR, 0, XCD_BAR_WORDS * 4, stream) != hipSuccess) { fprintf(stderr, "kernel_launch: memset failed\n"); return; }
    void* args[] = {&a};
    hipError_t e = hipLaunchCooperativeKernel((const void*)fwd_kernel, dim3(grid), dim3(NWAVES * 64), args, LDS_BYTES, stream);
    if (e != hipSuccess) fprintf(stderr, "cooperative launch failed: %s (grid %d)\n", hipGetErrorString(e), grid);
#endif
}
```
